# Optimizing an MI355X kernel written in HIP

```python
import jax, jax.numpy as jnp
from jax import lax
import numpy as np

D_MODEL = 1024
BATCH = 4
SEQ = 8192
DEPTH = 4
DEC_BATCH = 8
DEC_SEQ = 2048
PAST_LEN = 128

N_MIXERS = 2
N_GLA_LAYERS = (DEPTH + 1) // 2
N_SWA_LAYERS = DEPTH // 2
N_NORMS = 6
NORM_EPS = 1e-6

D_FF = 2816
FFN_RES = 0.5

GLA_HEADS = 4
GLA_DK = D_MODEL // 2 // GLA_HEADS
GLA_DV = D_MODEL // GLA_HEADS
GLA_QK = GLA_HEADS * GLA_DK
GLA_V = GLA_HEADS * GLA_DV
GLA_GATE_RANK = 16
GLA_TAU = 16.0
GLA_CHUNK = 64
GLA_IN = 2 * GLA_QK + 2 * GLA_V + 2 * GLA_GATE_RANK

SWA_Q_HEADS = 16
SWA_KV_HEADS = 4
SWA_GROUP = SWA_Q_HEADS // SWA_KV_HEADS
SWA_HD = 64
SWA_WINDOW = 128
SWA_BLOCK = 128
SWA_IN = (SWA_Q_HEADS + 2 * SWA_KV_HEADS) * SWA_HD
ROPE_THETA = 500000.0
ROPE_DIM = SWA_HD // 4
NEG_BIG = -1e30

kernel_name = "hybrid_gla_swa_macaron_encoder"


def rmsnorm(x, g):
    xf = x.astype(jnp.float32)
    xf = xf * lax.rsqrt(jnp.mean(xf * xf, axis=-1, keepdims=True) + NORM_EPS)
    return (xf * g.astype(jnp.float32)).astype(x.dtype)


def swiglu(x, w1, w2):
    gate, up = jnp.split(x @ w1, 2, axis=-1)
    return (jax.nn.silu(gate) * up) @ w2


def gla_chunked_causal(q, k, v, g):
    Bn, L, H, DK = q.shape
    DV = v.shape[-1]
    C = GLA_CHUNK
    N = L // C
    q = q.reshape(Bn, N, C, H, DK)
    k = k.reshape(Bn, N, C, H, DK)
    v = v.reshape(Bn, N, C, H, DV)
    b = jnp.cumsum(g.reshape(Bn, N, C, H, DK), axis=2)
    b_last = b[:, :, -1]
    q_dec = q * jnp.exp(b)
    k_inv = k * jnp.exp(-b)
    k_end = k * jnp.exp(b_last[:, :, None] - b)
    mask = jnp.tril(jnp.ones((C, C), dtype=bool))
    a = jnp.einsum('bnchk,bnshk->bnhcs', q_dec, k_inv)
    a = jnp.where(mask, a, 0.0)
    o_intra = jnp.einsum('bnhcs,bnshv->bnchv', a, v)

    def step(S, inp):
        q_c, k_c, v_c, dec = inp
        o = jnp.einsum('bchk,bhkv->bchv', q_c, S)
        S = dec[..., None] * S + jnp.einsum('bchk,bchv->bhkv', k_c, v_c)
        return S, o

    S0 = jnp.zeros((Bn, H, DK, DV), jnp.float32)
    xs = (jnp.moveaxis(q_dec, 1, 0), jnp.moveaxis(k_end, 1, 0),
          jnp.moveaxis(v, 1, 0), jnp.moveaxis(jnp.exp(b_last), 1, 0))
    _, o_inter = lax.scan(step, S0, xs)
    o = o_intra + jnp.moveaxis(o_inter, 0, 1)
    return o.reshape(Bn, L, H, DV)


def gla_mixer(x, w_in, w_gate_f, b_gate_f, w_gate_b, b_gate_b, g_onorm, w_out):
    Bn, L, _ = x.shape
    h = x @ w_in
    splits = [GLA_QK, 2 * GLA_QK, 2 * GLA_QK + GLA_V, 2 * GLA_QK + 2 * GLA_V,
              2 * GLA_QK + 2 * GLA_V + GLA_GATE_RANK]
    q, k, v, r, gd_f, gd_b = jnp.split(h, splits, axis=-1)
    q = q.reshape(Bn, L, GLA_HEADS, GLA_DK).astype(jnp.float32) * (GLA_DK ** -0.5)
    k = k.reshape(Bn, L, GLA_HEADS, GLA_DK).astype(jnp.float32)
    v = v.reshape(Bn, L, GLA_HEADS, GLA_DV).astype(jnp.float32)
    g_f = jax.nn.log_sigmoid((gd_f @ w_gate_f + b_gate_f).astype(jnp.float32)) / GLA_TAU
    g_b = jax.nn.log_sigmoid((gd_b @ w_gate_b + b_gate_b).astype(jnp.float32)) / GLA_TAU
    g_f = g_f.reshape(Bn, L, GLA_HEADS, GLA_DK)
    g_b = g_b.reshape(Bn, L, GLA_HEADS, GLA_DK)
    o_f = gla_chunked_causal(q, k, v, g_f)
    o_b = jnp.flip(gla_chunked_causal(jnp.flip(q, 1), jnp.flip(k, 1), jnp.flip(v, 1),
                                      jnp.flip(g_b, 1)), axis=1)
    o = o_f + o_b
    o = o * lax.rsqrt(jnp.mean(o * o, axis=-1, keepdims=True) + NORM_EPS)
    o = o.reshape(Bn, L, GLA_V) * g_onorm.astype(jnp.float32)
    o = o.astype(x.dtype) * jax.nn.silu(r)
    return o @ w_out


def rope_partial(x, pos):
    half = ROPE_DIM // 2
    inv_freq = ROPE_THETA ** (-(jnp.arange(half, dtype=jnp.float32) * 2.0 / ROPE_DIM))
    ang = pos.astype(jnp.float32)[:, None] * inv_freq[None, :]
    cos = jnp.cos(ang)[None, :, None, :]
    sin = jnp.sin(ang)[None, :, None, :]
    xr = x[..., :ROPE_DIM].astype(jnp.float32)
    x1, x2 = xr[..., :half], xr[..., half:]
    rot = jnp.concatenate([x1 * cos - x2 * sin, x2 * cos + x1 * sin], axis=-1)
    return jnp.concatenate([rot.astype(x.dtype), x[..., ROPE_DIM:]], axis=-1)


def swa_mixer(x, w_in, sinks, w_out):
    Bn, L, _ = x.shape
    h = x @ w_in
    q, k, v = jnp.split(h, [SWA_Q_HEADS * SWA_HD, (SWA_Q_HEADS + SWA_KV_HEADS) * SWA_HD], axis=-1)
    q = q.reshape(Bn, L, SWA_Q_HEADS, SWA_HD)
    k = k.reshape(Bn, L, SWA_KV_HEADS, SWA_HD)
    v = v.reshape(Bn, L, SWA_KV_HEADS, SWA_HD)
    pos = jnp.arange(L)
    q = rope_partial(q, pos) * (SWA_HD ** -0.5)
    k = rope_partial(k, pos)
    N = L // SWA_BLOCK
    q_blk = q.reshape(Bn, N, SWA_BLOCK, SWA_KV_HEADS, SWA_GROUP, SWA_HD)
    pad = ((0, 0), (SWA_BLOCK, SWA_BLOCK), (0, 0), (0, 0))
    k_pad = jnp.pad(k, pad).reshape(Bn, N + 2, SWA_BLOCK, SWA_KV_HEADS, SWA_HD)
    v_pad = jnp.pad(v, pad).reshape(Bn, N + 2, SWA_BLOCK, SWA_KV_HEADS, SWA_HD)
    k_band = jnp.concatenate([k_pad[:, 0:N], k_pad[:, 1:N + 1], k_pad[:, 2:N + 2]], axis=2)
    v_band = jnp.concatenate([v_pad[:, 0:N], v_pad[:, 1:N + 1], v_pad[:, 2:N + 2]], axis=2)
    s = jnp.einsum('bnqhgd,bnkhd->bnhgqk', q_blk, k_band).astype(jnp.float32)
    blk = jnp.arange(N)[:, None] * SWA_BLOCK
    qpos = blk + jnp.arange(SWA_BLOCK)[None, :]
    kpos = blk - SWA_BLOCK + jnp.arange(3 * SWA_BLOCK)[None, :]
    valid = (jnp.abs(qpos[:, :, None] - kpos[:, None, :]) <= SWA_WINDOW) \
        & ((kpos >= 0) & (kpos < L))[:, None, :]
    s = jnp.where(valid[None, :, None, None, :, :], s, NEG_BIG)
    sink = jnp.broadcast_to(
        sinks.astype(jnp.float32).reshape(1, 1, SWA_KV_HEADS, SWA_GROUP, 1, 1), s.shape[:-1] + (1,))
    p = jax.nn.softmax(jnp.concatenate([s, sink], axis=-1), axis=-1)[..., :-1]
    o = jnp.einsum('bnhgqk,bnkhd->bnqhgd', p.astype(v.dtype), v_band)
    o = o.reshape(Bn, L, SWA_Q_HEADS * SWA_HD)
    return o @ w_out


def trunk(x, norm_g, ffn_w1, ffn_w2, gla_w_in, gla_w_gate_f, gla_b_gate_f, gla_w_gate_b,
          gla_b_gate_b, gla_onorm, gla_w_out, swa_w_in, swa_sinks, swa_w_out):
    for i in range(DEPTH):
        g = norm_g[i]
        h = swiglu(rmsnorm(x, g[0]), ffn_w1[i, 0], ffn_w2[i, 0])
        x = x + FFN_RES * rmsnorm(h, g[1])
        h = rmsnorm(x, g[2])
        j = i // N_MIXERS
        if i % N_MIXERS == 0:
            h = gla_mixer(h, gla_w_in[j], gla_w_gate_f[j], gla_b_gate_f[j], gla_w_gate_b[j],
                          gla_b_gate_b[j], gla_onorm[j], gla_w_out[j])
        else:
            h = swa_mixer(h, swa_w_in[j], swa_sinks[j], swa_w_out[j])
        x = x + rmsnorm(h, g[3])
        h = swiglu(rmsnorm(x, g[4]), ffn_w1[i, 1], ffn_w2[i, 1])
        x = x + FFN_RES * rmsnorm(h, g[5])
    return x


def setup_inputs(seed: int = 0) -> dict:
    key = jax.random.key(seed)
    ks = jax.random.split(key, 16)
    f32 = jnp.float32
    nrm = lambda k, shape, scale: jax.random.normal(k, shape, f32) * scale
    return {
        "x_prompt": nrm(ks[0], (BATCH, SEQ, D_MODEL), 1.0),
        "x_sample": nrm(ks[1], (DEC_BATCH, DEC_SEQ, D_MODEL), 1.0),
        "norm_g": 1.0 + nrm(ks[2], (DEPTH, N_NORMS, D_MODEL), 0.05),
        "ffn_w1": nrm(ks[3], (DEPTH, 2, D_MODEL, 2 * D_FF), D_MODEL ** -0.5),
        "ffn_w2": nrm(ks[4], (DEPTH, 2, D_FF, D_MODEL), D_FF ** -0.5),
        "gla_w_in": nrm(ks[5], (N_GLA_LAYERS, D_MODEL, GLA_IN), D_MODEL ** -0.5),
        "gla_w_gate_f": nrm(ks[6], (N_GLA_LAYERS, GLA_GATE_RANK, GLA_QK), GLA_GATE_RANK ** -0.5),
        "gla_b_gate_f": nrm(ks[7], (N_GLA_LAYERS, GLA_QK), 0.1),
        "gla_w_gate_b": nrm(ks[8], (N_GLA_LAYERS, GLA_GATE_RANK, GLA_QK), GLA_GATE_RANK ** -0.5),
        "gla_b_gate_b": nrm(ks[9], (N_GLA_LAYERS, GLA_QK), 0.1),
        "gla_onorm": 1.0 + nrm(ks[10], (N_GLA_LAYERS, GLA_V), 0.05),
        "gla_w_out": nrm(ks[11], (N_GLA_LAYERS, GLA_V, D_MODEL), GLA_V ** -0.5),
        "swa_w_in": nrm(ks[12], (N_SWA_LAYERS, D_MODEL, SWA_IN), D_MODEL ** -0.5),
        "swa_sinks": nrm(ks[13], (N_SWA_LAYERS, SWA_Q_HEADS), 1.0),
        "swa_w_out": nrm(ks[14], (N_SWA_LAYERS, SWA_Q_HEADS * SWA_HD, D_MODEL), (SWA_Q_HEADS * SWA_HD) ** -0.5),
    }


def reference(x_prompt, x_sample, norm_g, ffn_w1, ffn_w2, gla_w_in, gla_w_gate_f, gla_b_gate_f,
              gla_w_gate_b, gla_b_gate_b, gla_onorm, gla_w_out, swa_w_in, swa_sinks, swa_w_out):
    y_prompt = trunk(x_prompt, norm_g, ffn_w1, ffn_w2, gla_w_in, gla_w_gate_f, gla_b_gate_f,
                     gla_w_gate_b, gla_b_gate_b, gla_onorm, gla_w_out, swa_w_in, swa_sinks, swa_w_out)
    y_sample = trunk(x_sample, norm_g, ffn_w1, ffn_w2, gla_w_in, gla_w_gate_f, gla_b_gate_f,
                     gla_w_gate_b, gla_b_gate_b, gla_onorm, gla_w_out, swa_w_in, swa_sinks, swa_w_out)
    return (y_prompt, y_sample)
```

```cpp
#include <hip/hip_runtime.h>
#include <hip/hip_cooperative_groups.h>
#include <cstdio>
#include <cstdint>
#include <cmath>
namespace cg = cooperative_groups;
#ifndef MK_MULTI_LAUNCH
#define MK_MULTI_LAUNCH 0
#endif
constexpr size_t MiB = 1u << 20;
constexpr size_t WS_ROPE = 0, WS_RS = 1 * MiB;
constexpr size_t WS_W1A = 4 * MiB, WS_W1B = 15 * MiB, WS_W2A = 26 * MiB, WS_W2B = 32 * MiB, WS_WMI = 38 * MiB, WS_WMO = 45 * MiB;
constexpr size_t WS_XB = 48 * MiB;
constexpr size_t WS_H = 144 * MiB;
constexpr size_t WS_B = 240 * MiB;
constexpr size_t WS_GV = 240 * MiB, WS_GR = 336 * MiB, WS_GD = 432 * MiB, WS_DEC = 438 * MiB, WS_ST = 440 * MiB;
constexpr size_t WS_SQ = 240 * MiB, WS_SK = 336 * MiB, WS_SV = 360 * MiB, WS_SO = 384 * MiB;
constexpr size_t WS_END = 632 * MiB;

namespace pg8 {
#define PG8_LAS __attribute__((address_space(3)))
typedef unsigned short bf16_t;
typedef short bf16x8 __attribute__((ext_vector_type(8)));
typedef float f32x4 __attribute__((ext_vector_type(4)));
typedef unsigned u32x4 __attribute__((ext_vector_type(4)));
constexpr int BM = 256, BK = 64, HALF = 128, HTB = HALF * BK * 2  , STAGE_BYTES = 8 * HTB, NXCD = 8, WGM = 8;

__host__ __device__ __forceinline__ int lds_byte(int r, int c) { const int st = (r >> 4) * 2 + (c >> 5), rr = r & 15, cc = c & 31, ob = rr * 64 + cc * 2; return st * 1024 + (ob ^ (((ob >> 9) & 1) << 5)); }
__host__ __device__ __forceinline__ void stage_rc(int b, int& R, int& C) { const int st = b / 1024, sb = b % 1024, swz = sb ^ (((sb >> 9) & 1) << 5); R = (st >> 1) * 16 + swz / 64; C = (st & 1) * 32 + (swz % 64) / 2; }
__host__ __device__ __forceinline__ int perm32(int rho) { const int n = rho >> 4, i = rho & 15; return 8 * (i >> 2) + 4 * n + (i & 3); }

struct Unit { int pm, pn; };
struct Gemm { const bf16_t* A; const bf16_t* Bt; int M, N, K; };

struct StaticOrder {
    int nM, nN, nwg, G, c;
    __host__ __device__ void init(int M, int N, int G_, int c_) { nM = M / BM; nN = N / BM; nwg = nM * nN; G = G_; c = c_; }
    __host__ __device__ bool next(int i, Unit& u) const {
        const long L = (long)i * G + c; if (L >= nwg) return false;
        int wgid = (int)L; { const int q = nwg / NXCD, r = nwg % NXCD, xcd = wgid % NXCD, off = wgid / NXCD; wgid = (xcd < r ? xcd * (q + 1) : r * (q + 1) + (xcd - r) * q) + off; }
        const int nig = WGM * nN, gid = wgid / nig, fm = gid * WGM, gsz = (nM - fm) < WGM ? (nM - fm) : WGM;
        u.pm = fm + ((wgid % nig) % gsz); u.pn = (wgid % nig) / gsz; return true;
    }
    __device__ __forceinline__ void a_ready(const Unit&) const {}
    __device__ __forceinline__ void done(const Unit&) const {}
};
__device__ __forceinline__ unsigned cvt_pk_bf16(float lo, float hi) { unsigned r; asm volatile("v_cvt_pk_bf16_f32 %0, %1, %2" : "=v"(r) : "v"(lo), "v"(hi)); return r; }
typedef float f32x2 __attribute__((ext_vector_type(2)));
typedef unsigned u32x2 __attribute__((ext_vector_type(2)));
__device__ __forceinline__ float silu_f(float v) { return v * __builtin_amdgcn_rcpf(1.0f + __expf(-v)); }
__device__ __forceinline__ f32x4 silu4(f32x4 v) { return (f32x4){silu_f(v[0]), silu_f(v[1]), silu_f(v[2]), silu_f(v[3])}; }
__device__ __forceinline__ u32x4 pack8(f32x4 a, f32x4 b) { u32x4 w; w.x = cvt_pk_bf16(a[0], a[1]); w.y = cvt_pk_bf16(a[2], a[3]); w.z = cvt_pk_bf16(b[0], b[1]); w.w = cvt_pk_bf16(b[2], b[3]); return w; }

struct EpiPlain {
    static constexpr bool PERM = true, AFTER_DRAIN = false;
    bf16_t* O; int ldc;
    __device__ __forceinline__ void operator()(const f32x4 (&acc)[2][2][4][2], const Unit& u, int wr, int wc, int fr, int fq) const {
        const int row0 = u.pm * BM + wr * 64 + fr, col0 = u.pn * BM + wc * 32 + 8 * fq;
#pragma unroll
        for (int ai = 0; ai < 2; ++ai)
#pragma unroll
            for (int m = 0; m < 4; ++m) { bf16_t* rowp = O + (size_t)(row0 + ai * HALF + m * 16) * ldc + col0;
#pragma unroll
                for (int bj = 0; bj < 2; ++bj) *(u32x4*)(rowp + bj * HALF) = pack8(acc[ai][bj][m][0], acc[ai][bj][m][1]); }
    }
};
struct EpiSwiGLU {
    static constexpr bool PERM = true, AFTER_DRAIN = false;
    bf16_t* O; const float* rs;
    __device__ __forceinline__ void operator()(const f32x4 (&acc)[2][2][4][2], const Unit& u, int wr, int wc, int fr, int fq) const {
        const int row0 = u.pm * BM + wr * 64 + fr, col0 = u.pn * HALF + wc * 32 + 8 * fq;
#pragma unroll
        for (int ai = 0; ai < 2; ++ai)
#pragma unroll
            for (int m = 0; m < 4; ++m) { const int row = row0 + ai * HALF + m * 16; const float r = rs[row];
                const f32x4 g0 = acc[ai][0][m][0] * r, g1 = acc[ai][0][m][1] * r, u0 = acc[ai][1][m][0] * r, u1 = acc[ai][1][m][1] * r;
                *(u32x4*)(O + (size_t)row * 2816 + col0) = pack8(silu4(g0) * u0, silu4(g1) * u1); }
    }
};
struct EpiGlaIn {
    static constexpr bool PERM = true, AFTER_DRAIN = false;
    unsigned char* ws; const float* rs;
    __device__ __forceinline__ void operator()(const f32x4 (&acc)[2][2][4][2], const Unit& u, int wr, int wc, int fr, int fq) const {
        const int row0 = u.pm * BM + wr * 64 + fr, pn = u.pn;
        if (pn == 12) {
            if (wc == 0) {
#pragma unroll
                for (int ai = 0; ai < 2; ++ai)
#pragma unroll
                    for (int m = 0; m < 4; ++m) { const int row = row0 + ai * HALF + m * 16; const float r = rs[row]; float* gp = (float*)(ws + WS_GD) + (size_t)row * 32 + 8 * fq;
                        *(f32x4*)(gp) = acc[ai][0][m][0] * r; *(f32x4*)(gp + 4) = acc[ai][0][m][1] * r; }
            }
            return;
        }
        bf16_t* base = (bf16_t*)(ws + (pn < 4 ? WS_H : (pn < 8 ? WS_GV : WS_GR)));
        const int col0 = (pn & 3) * BM + wc * 32 + 8 * fq;
        const float sc = pn < 2 ? 0.08838834764831845f : 1.0f;
#pragma unroll
        for (int ai = 0; ai < 2; ++ai)
#pragma unroll
            for (int m = 0; m < 4; ++m) { const int row = row0 + ai * HALF + m * 16; const float r = rs[row] * sc; bf16_t* rowp = base + (size_t)row * 1024 + col0;
#pragma unroll
                for (int bj = 0; bj < 2; ++bj) { f32x4 v0 = acc[ai][bj][m][0] * r, v1 = acc[ai][bj][m][1] * r;
                    if (pn >= 8) { v0 = silu4(v0); v1 = silu4(v1); }
                    *(u32x4*)(rowp + bj * HALF) = pack8(v0, v1); } }
    }
};
struct EpiSwaIn {
    static constexpr bool PERM = true, AFTER_DRAIN = false;
    unsigned char* ws; const float* rs;
    __device__ __forceinline__ void operator()(const f32x4 (&acc)[2][2][4][2], const Unit& u, int wr, int wc, int fr, int fq) const {
        const int row0 = u.pm * BM + wr * 64 + fr, pn = u.pn;
        bf16_t* base = (bf16_t*)(ws + (pn < 4 ? WS_SQ : (pn == 4 ? WS_SK : WS_SV))); const int ldc = pn < 4 ? 1024 : 256;
        const int col0 = (pn < 4 ? pn * BM : 0) + wc * 32 + 8 * fq;
        const bool do_rope = (pn <= 4) && ((wc & 1) == 0);
        const float qs = pn < 4 ? 0.125f : 1.0f;
#pragma unroll
        for (int ai = 0; ai < 2; ++ai)
#pragma unroll
            for (int m = 0; m < 4; ++m) { const int row = row0 + ai * HALF + m * 16; const float r = rs[row]; bf16_t* rowp = base + (size_t)row * ldc + col0;
                const int pos = row < 32768 ? (row & 8191) : (row & 2047);
#pragma unroll
                for (int bj = 0; bj < 2; ++bj) { f32x4 v0 = acc[ai][bj][m][0] * r, v1 = acc[ai][bj][m][1] * r;
                    if (do_rope) {
                        f32x4 p0, p1;
#pragma unroll
                        for (int j = 0; j < 4; ++j) { p0[j] = __shfl_xor(v0[j], 16); p1[j] = __shfl_xor(v1[j], 16); }
                        if (fq < 2) {
                            const float* rp = (const float*)(ws + WS_ROPE) + (size_t)pos * 16;
                            const f32x4 c0 = *(const f32x4*)(rp), c1 = *(const f32x4*)(rp + 4), s0 = *(const f32x4*)(rp + 8), s1 = *(const f32x4*)(rp + 12);
                            if (fq == 0) { v0 = v0 * c0 - p0 * s0; v1 = v1 * c1 - p1 * s1; }
                            else         { v0 = v0 * c0 + p0 * s0; v1 = v1 * c1 + p1 * s1; }
                        }
                    }
                    v0 = v0 * qs; v1 = v1 * qs;
                    *(u32x4*)(rowp + bj * HALF) = pack8(v0, v1); } }
    }
};
template <class Epi, class Sched, bool ALIGN_EPI = false, bool SP2 = false>
__device__ __forceinline__ void gemm_phase(PG8_LAS unsigned char* lds, const Gemm g, const Sched& S, const Epi& E, int tid_in) {
    const int tid = tid_in, wid = __builtin_amdgcn_readfirstlane(tid >> 6), lane = tid & 63, wr = wid >> 2, wc = wid & 3, fr = lane & 15, fq = lane >> 4;
    const int K = g.K, nt = K / BK;
    unsigned voffA[2], voffB[2];
#pragma unroll
    for (int i = 0; i < 2; ++i) { int R, C; stage_rc(tid * 16 + i * 8192, R, C); const int Rb = Epi::PERM ? ((R & ~31) + perm32(R & 31)) : R;
        voffA[i] = (unsigned)(R * K + C) * 2u; voffB[i] = (unsigned)(Rb * K + C) * 2u; }
    const size_t kstep = (size_t)(BK * 2);
    const size_t hstep = (size_t)HALF * K * 2;
    const size_t tstep = 2 * hstep;
    const unsigned ldsw = (unsigned)wid * 1024u;
    const int aoff = lds_byte(wr * 64 + fr, fq * 8), boff = lds_byte(wc * 32 + fr, fq * 8);
#define PG8_SA(b, h) (((b) * 2 + (h)) * HTB)
#define PG8_SB(b, h) ((4 + (b) * 2 + (h)) * HTB)
#define PG8_STAGE(bufoff, gbase, voff) do { _Pragma("unroll") for (int _i = 0; _i < 2; ++_i) \
        __builtin_amdgcn_global_load_lds((const unsigned*)((const char*)(gbase) + (voff)[_i]), (PG8_LAS unsigned*)(lds + (bufoff) + ldsw + _i * 8192), 16, 0, 0); } while (0)
#define PG8_LDA(dst, b, h) do { _Pragma("unroll") for (int m = 0; m < 4; ++m) _Pragma("unroll") for (int k = 0; k < 2; ++k) dst[m][k] = *(const PG8_LAS bf16x8*)(lds + PG8_SA(b, h) + aoff + m * 2048 + k * 1024); } while (0)
#define PG8_LDB(dst, b, h) do { _Pragma("unroll") for (int n = 0; n < 2; ++n) _Pragma("unroll") for (int k = 0; k < 2; ++k) dst[n][k] = *(const PG8_LAS bf16x8*)(lds + PG8_SB(b, h) + boff + n * 2048 + k * 1024); } while (0)
#define PG8_MMA(ai, bj, At, Bt) do { __builtin_amdgcn_s_setprio(1); _Pragma("unroll") for (int m = 0; m < 4; ++m) _Pragma("unroll") for (int n = 0; n < 2; ++n) _Pragma("unroll") for (int k = 0; k < 2; ++k) \
        acc[ai][bj][m][n] = __builtin_amdgcn_mfma_f32_16x16x32_bf16(Bt[n][k], At[m][k], acc[ai][bj][m][n], 0, 0, 0); __builtin_amdgcn_s_setprio(0); } while (0)
#define PG8_WAIT_V(n) asm volatile("s_waitcnt vmcnt(" #n ")" ::: "memory")
#define PG8_WAIT_L(n) asm volatile("s_waitcnt lgkmcnt(" #n ")" ::: "memory")
#define PG8_BAR __builtin_amdgcn_s_barrier()
#define PG8_SCHED __builtin_amdgcn_sched_barrier(0)
    Unit cur, nxt; int ui = 0;
    if (!S.next(0, cur)) return;
    f32x4 acc[2][2][4][2];
#pragma unroll
    for (int a = 0; a < 2; ++a)
#pragma unroll
        for (int b = 0; b < 2; ++b)
#pragma unroll
            for (int m = 0; m < 4; ++m)
#pragma unroll
                for (int n = 0; n < 2; ++n) acc[a][b][m][n] = (f32x4){0.f, 0.f, 0.f, 0.f};
    bf16x8 At[4][2], B0[2][2], B1[2][2];
    const char* cA = (const char*)g.A + (size_t)cur.pm * tstep; const char* cB = (const char*)g.Bt + (size_t)cur.pn * tstep;
    S.a_ready(cur);
    if constexpr (SP2) {
        PG8_STAGE(PG8_SB(0, 0), cB, voffB); PG8_STAGE(PG8_SB(0, 1), cB + hstep, voffB); PG8_STAGE(PG8_SA(0, 0), cA, voffA); PG8_STAGE(PG8_SA(0, 1), cA + hstep, voffA);
        if (wr == 1) PG8_BAR;
        PG8_WAIT_V(2); PG8_BAR;
        PG8_STAGE(PG8_SB(1, 0), cB + kstep, voffB); PG8_STAGE(PG8_SA(1, 0), cA + kstep, voffA); PG8_STAGE(PG8_SB(1, 1), cB + hstep + kstep, voffB);
        PG8_WAIT_V(6); PG8_BAR;
    } else {
        PG8_STAGE(PG8_SB(0, 0), cB, voffB); PG8_STAGE(PG8_SA(0, 0), cA, voffA); PG8_STAGE(PG8_SB(0, 1), cB + hstep, voffB); PG8_STAGE(PG8_SA(0, 1), cA + hstep, voffA);
        if (wr == 1) PG8_BAR;
        PG8_WAIT_V(4); PG8_BAR;
        PG8_STAGE(PG8_SB(1, 0), cB + kstep, voffB); PG8_STAGE(PG8_SA(1, 0), cA + kstep, voffA); PG8_STAGE(PG8_SB(1, 1), cB + hstep + kstep, voffB);
        PG8_WAIT_V(6); PG8_BAR;
    }
    for (;;) {
        const bool has_next = S.next(ui + 1, nxt);
        const char* nA = has_next ? (const char*)g.A + (size_t)nxt.pm * tstep : cA; const char* nB = has_next ? (const char*)g.Bt + (size_t)nxt.pn * tstep : cB;
        for (int t = 0; t < nt; t += 2) {
            const bool last = (t == nt - 2);
            const char* a1 = cA + (size_t)(t + 1) * kstep;
            const char* a2 = last ? nA : cA + (size_t)(t + 2) * kstep; const char* b2 = last ? nB : cB + (size_t)(t + 2) * kstep;
            const char* a3 = a2 + kstep; const char* b3 = b2 + kstep;
            if (last && has_next) S.a_ready(nxt);
            if constexpr (SP2) {
            PG8_LDB(B0, 0, 0); PG8_LDB(B1, 0, 1); PG8_SCHED; PG8_LDA(At, 0, 0); PG8_STAGE(PG8_SA(1, 1), a1 + hstep, voffA);
            PG8_WAIT_V(8); PG8_WAIT_L(0); PG8_BAR; PG8_MMA(0, 0, At, B0); PG8_MMA(0, 1, At, B1); PG8_BAR; PG8_SCHED;
            PG8_LDA(At, 0, 1); PG8_STAGE(PG8_SB(0, 0), b2, voffB); PG8_STAGE(PG8_SB(0, 1), b2 + hstep, voffB); PG8_STAGE(PG8_SA(0, 0), a2, voffA);
            PG8_WAIT_V(8); PG8_WAIT_L(0); PG8_BAR; PG8_MMA(1, 0, At, B0); PG8_MMA(1, 1, At, B1); PG8_BAR; PG8_SCHED;
            PG8_LDB(B0, 1, 0); PG8_LDB(B1, 1, 1); PG8_SCHED; PG8_LDA(At, 1, 0); PG8_STAGE(PG8_SA(0, 1), a2 + hstep, voffA);
            PG8_WAIT_V(8); PG8_WAIT_L(0); PG8_BAR; PG8_MMA(0, 0, At, B0); PG8_MMA(0, 1, At, B1); PG8_BAR; PG8_SCHED;
            PG8_LDA(At, 1, 1); PG8_STAGE(PG8_SB(1, 0), b3, voffB); PG8_STAGE(PG8_SB(1, 1), b3 + hstep, voffB); PG8_STAGE(PG8_SA(1, 0), a3, voffA);
            PG8_WAIT_V(8); PG8_WAIT_L(0); PG8_BAR; PG8_MMA(1, 0, At, B0); PG8_MMA(1, 1, At, B1); PG8_BAR; PG8_SCHED;
            } else {
            PG8_LDB(B0, 0, 0); PG8_SCHED; PG8_LDA(At, 0, 0); PG8_STAGE(PG8_SA(1, 1), a1 + hstep, voffA);
            PG8_WAIT_L(8); PG8_BAR; PG8_WAIT_L(0); PG8_MMA(0, 0, At, B0); PG8_BAR; PG8_SCHED;
            PG8_LDB(B1, 0, 1); PG8_STAGE(PG8_SB(0, 0), b2, voffB);
            PG8_BAR; PG8_WAIT_L(0); PG8_MMA(0, 1, At, B1); PG8_BAR;
            PG8_LDA(At, 0, 1); PG8_STAGE(PG8_SA(0, 0), a2, voffA);
            PG8_BAR; PG8_WAIT_L(0); PG8_MMA(1, 0, At, B0); PG8_BAR; PG8_SCHED;
            PG8_STAGE(PG8_SB(0, 1), b2 + hstep, voffB);
            PG8_WAIT_V(6); PG8_BAR; PG8_MMA(1, 1, At, B1); PG8_BAR;
            PG8_LDB(B0, 1, 0); PG8_SCHED; PG8_LDA(At, 1, 0); PG8_STAGE(PG8_SA(0, 1), a2 + hstep, voffA);
            PG8_WAIT_L(8); PG8_BAR; PG8_WAIT_L(0); PG8_MMA(0, 0, At, B0); PG8_BAR; PG8_SCHED;
            PG8_LDB(B1, 1, 1); PG8_STAGE(PG8_SB(1, 0), b3, voffB);
            PG8_BAR; PG8_WAIT_L(0); PG8_MMA(0, 1, At, B1); PG8_BAR;
            PG8_LDA(At, 1, 1); PG8_STAGE(PG8_SA(1, 0), a3, voffA);
            PG8_BAR; PG8_WAIT_L(0); PG8_MMA(1, 0, At, B0); PG8_BAR; PG8_SCHED;
            PG8_STAGE(PG8_SB(1, 1), b3 + hstep, voffB);
            PG8_WAIT_V(6); PG8_BAR; PG8_MMA(1, 1, At, B1); PG8_BAR;
            }
        }
        if constexpr (ALIGN_EPI) { if (wr == 0) PG8_BAR; }
        if constexpr (!Epi::AFTER_DRAIN) { E(acc, cur, wr, wc, fr, fq); S.done(cur); }
        if (!has_next) break;
#pragma unroll
        for (int a = 0; a < 2; ++a)
#pragma unroll
            for (int b = 0; b < 2; ++b)
#pragma unroll
                for (int m = 0; m < 4; ++m)
#pragma unroll
                    for (int n = 0; n < 2; ++n) acc[a][b][m][n] = (f32x4){0.f, 0.f, 0.f, 0.f};
        cur = nxt; cA = nA; cB = nB; ++ui;
        if constexpr (ALIGN_EPI) { if (wr == 1) PG8_BAR; }
    }
    PG8_WAIT_V(0);
    if constexpr (!ALIGN_EPI) { if (wr == 0) PG8_BAR; }
    PG8_BAR;
    if constexpr (Epi::AFTER_DRAIN) { E.fused(acc, cur, wr, wc, fr, fq, lds, wid, lane); S.done(cur); }
#undef PG8_SA
#undef PG8_SB
#undef PG8_STAGE
#undef PG8_LDA
#undef PG8_LDB
#undef PG8_MMA
#undef PG8_WAIT_V
#undef PG8_WAIT_L
#undef PG8_BAR
#undef PG8_SCHED
}
}

#define LAS __attribute__((address_space(3)))
typedef unsigned short bf16_t;
typedef short bf16x8 __attribute__((ext_vector_type(8)));
typedef short s16x4 __attribute__((ext_vector_type(4)));
typedef float f32x4 __attribute__((ext_vector_type(4)));
typedef unsigned u32x4 __attribute__((ext_vector_type(4)));
typedef unsigned u32x2 __attribute__((ext_vector_type(2)));
constexpr int T_TOK = 49152, DM = 1024, DFF = 2816, NLAYER = 4;
constexpr int GLA_N = 3104, GLA_NP = 3328, SWA_N = 1536;
constexpr float NORM_EPS = 1e-6f;
constexpr int NWAVES = 8;
constexpr int LDS_BYTES = 147456;
__device__ __forceinline__ unsigned f2bf(float f) { unsigned u = __builtin_bit_cast(unsigned, f); return (u + 0x7fffu + ((u >> 16) & 1u)) >> 16; }
__device__ __forceinline__ unsigned pk2(float lo, float hi) { return pg8::cvt_pk_bf16(lo, hi); }
__device__ __forceinline__ float bflo(unsigned w) { return __builtin_bit_cast(float, w << 16); }
__device__ __forceinline__ float bfhi(unsigned w) { return __builtin_bit_cast(float, w & 0xffff0000u); }
__device__ __forceinline__ float bf2f(bf16_t b) { return __builtin_bit_cast(float, ((unsigned)b) << 16); }
__device__ __forceinline__ float wave_sum(float v) {
#pragma unroll
    for (int o = 1; o < 64; o <<= 1) v += __shfl_xor(v, o);
    return v;
}
typedef short v4i16_t __attribute__((ext_vector_type(4)));
__device__ __forceinline__ s16x4 vtr(LAS const unsigned char* p) { return __builtin_bit_cast(s16x4, __builtin_amdgcn_ds_read_tr16_b64_v4i16((LAS v4i16_t*)p)); }
__device__ __forceinline__ bf16x8 cat8(s16x4 lo, s16x4 hi) { return (bf16x8){lo[0], lo[1], lo[2], lo[3], hi[0], hi[1], hi[2], hi[3]}; }
__device__ __forceinline__ bf16x8 packp(f32x4 a, f32x4 b) { u32x4 w; w.x = pk2(a[0], a[1]); w.y = pk2(a[2], a[3]); w.z = pk2(b[0], b[1]); w.w = pk2(b[2], b[3]); return __builtin_bit_cast(bf16x8, w); }
#define MFMA16(a, b, c) __builtin_amdgcn_mfma_f32_16x16x32_bf16((a), (b), (c), 0, 0, 0)
#define LDS_WAIT() asm volatile("s_waitcnt lgkmcnt(0)" ::: "memory")

__device__ __forceinline__ void tr_item(const float* W, const float* g, int K, int N, bf16_t* WT, int k0, int n0, int drow0, LAS float* scr, int lane) {
#pragma unroll 8
    for (int i = 0; i < 32; ++i) { const int kk = 2 * i + (lane >> 5); const float gv = g ? g[k0 + kk] : 1.0f; scr[kk * 33 + (lane & 31)] = W[(size_t)(k0 + kk) * N + n0 + (lane & 31)] * gv; }
    LDS_WAIT(); asm volatile("" ::: "memory");
    const int c = lane & 7;
#pragma unroll
    for (int j = 0; j < 4; ++j) { const int n = (lane >> 3) + 8 * j; const LAS float* s = scr + (8 * c) * 33 + n;
        u32x4 o; o.x = pk2(s[0 * 33], s[1 * 33]); o.y = pk2(s[2 * 33], s[3 * 33]); o.z = pk2(s[4 * 33], s[5 * 33]); o.w = pk2(s[6 * 33], s[7 * 33]);
        *(u32x4*)(WT + (size_t)(drow0 + n) * K + k0 + 8 * c) = o; }
    LDS_WAIT(); asm volatile("" ::: "memory");
}
struct Ptrs {
    const float *xp, *xs, *norm_g, *w1, *w2, *gla_in, *wgf, *bgf, *wgb, *bgb, *onorm, *gla_out, *swa_in, *sinks, *swa_out;
    float* out; unsigned char* ws;
};
__device__ __forceinline__ void convert_layer(const Ptrs& P, int L, LAS unsigned char* lds, int gw, int NGW, int wave, int lane) {
    LAS float* scr = (LAS float*)(lds + wave * 8448);
    const bool gla = (L & 1) == 0; const int j = L >> 1;
    const float* g = P.norm_g + (size_t)L * 6 * 1024;
    constexpr int I_W1 = 16 * 176, I_W2 = 44 * 32, I_GI = 16 * 97, I_SI = 16 * 48, I_MO = 16 * 32;
    const int i_mi = gla ? I_GI : I_SI;
    const int total = 2 * I_W1 + 2 * I_W2 + i_mi + I_MO;
    for (int it = gw; it < total; it += NGW) {
        int r = it;
        if (r < 2 * I_W1) { const int s = r / I_W1; r -= s * I_W1; const int kb = r / 176, nb = r % 176, n0 = nb * 32;
            const int jj = n0 < 2816 ? n0 : n0 - 2816; const int drow = 256 * (jj >> 7) + (n0 < 2816 ? 0 : 128) + (jj & 127);
            tr_item(P.w1 + (size_t)(L * 2 + s) * 1024 * 5632, g + (s ? 4 : 0) * 1024, 1024, 5632, (bf16_t*)(P.ws + (s ? WS_W1B : WS_W1A)), kb * 64, n0, drow, scr, lane); continue; }
        r -= 2 * I_W1;
        if (r < 2 * I_W2) { const int s = r / I_W2; r -= s * I_W2; const int kb = r / 32, nb = r % 32;
            tr_item(P.w2 + (size_t)(L * 2 + s) * 2816 * 1024, nullptr, 2816, 1024, (bf16_t*)(P.ws + (s ? WS_W2B : WS_W2A)), kb * 64, nb * 32, nb * 32, scr, lane); continue; }
        r -= 2 * I_W2;
        if (r < i_mi) {
            if (gla) { const int kb = r / 97, nb = r % 97; tr_item(P.gla_in + (size_t)j * 1024 * GLA_N, g + 2 * 1024, 1024, GLA_N, (bf16_t*)(P.ws + WS_WMI), kb * 64, nb * 32, nb * 32, scr, lane); }
            else     { const int kb = r / 48, nb = r % 48; tr_item(P.swa_in + (size_t)j * 1024 * SWA_N, g + 2 * 1024, 1024, SWA_N, (bf16_t*)(P.ws + WS_WMI), kb * 64, nb * 32, nb * 32, scr, lane); }
            continue; }
        r -= i_mi;
        { const int kb = r / 32, nb = r % 32; tr_item((gla ? P.gla_out : P.swa_out) + (size_t)j * 1024 * 1024, nullptr, 1024, 1024, (bf16_t*)(P.ws + WS_WMO), kb * 64, nb * 32, nb * 32, scr, lane); }
    }
    if (gla) {
        u32x4* z = (u32x4*)(P.ws + WS_WMI + (size_t)GLA_N * 1024 * 2);
        for (int i = gw * 64 + lane; i < 224 * 128; i += NGW * 64) z[i] = (u32x4){0u, 0u, 0u, 0u};
    }
}

__device__ __forceinline__ void init_rows(const Ptrs& P, int gw, int NGW, int lane) {
    float* X = P.out; bf16_t* XB = (bf16_t*)(P.ws + WS_XB); float* RS = (float*)(P.ws + WS_RS);
    for (int row = gw; row < T_TOK; row += NGW) {
        const float* src = row < 32768 ? P.xp + (size_t)row * DM : P.xs + (size_t)(row - 32768) * DM;
        const f32x4* xr = (const f32x4*)src + lane; f32x4* xo = (f32x4*)(X + (size_t)row * DM) + lane; u32x2* bo = (u32x2*)(XB + (size_t)row * DM) + lane;
        float s2 = 0.f;
#pragma unroll
        for (int j = 0; j < 4; ++j) { const f32x4 v = xr[64 * j]; s2 += (v[0] * v[0] + v[1] * v[1]) + (v[2] * v[2] + v[3] * v[3]); xo[64 * j] = v; bo[64 * j] = (u32x2){pk2(v[0], v[1]), pk2(v[2], v[3])}; }
        s2 = wave_sum(s2);
        if (lane == 0) RS[row] = rsqrtf(s2 * (1.0f / DM) + NORM_EPS);
    }
}
__device__ __forceinline__ void nr_rows(const Ptrs& P, const float* g, float c, int gw, int NGW, int lane) {
    float* X = P.out; bf16_t* XB = (bf16_t*)(P.ws + WS_XB); float* RS = (float*)(P.ws + WS_RS); const bf16_t* H = (const bf16_t*)(P.ws + WS_H);
    f32x4 gv[4];
#pragma unroll
    for (int j = 0; j < 4; ++j) gv[j] = ((const f32x4*)g)[lane + 64 * j];
    for (int row = gw; row < T_TOK; row += NGW) {
        f32x4* xr = (f32x4*)(X + (size_t)row * DM) + lane; const u32x2* hr = (const u32x2*)(H + (size_t)row * DM) + lane; u32x2* bo = (u32x2*)(XB + (size_t)row * DM) + lane;
        f32x4 xv[4], hv[4]; float ss = 0.f;
#pragma unroll
        for (int j = 0; j < 4; ++j) { xv[j] = xr[64 * j]; const u32x2 hw = hr[64 * j]; hv[j] = (f32x4){bflo(hw.x), bfhi(hw.x), bflo(hw.y), bfhi(hw.y)};
            ss += (hv[j][0] * hv[j][0] + hv[j][1] * hv[j][1]) + (hv[j][2] * hv[j][2] + hv[j][3] * hv[j][3]); }
        ss = wave_sum(ss);
        const float rs = rsqrtf(ss * (1.0f / DM) + NORM_EPS) * c; float s2 = 0.f;
#pragma unroll
        for (int j = 0; j < 4; ++j) { const f32x4 v = xv[j] + hv[j] * rs * gv[j]; s2 += (v[0] * v[0] + v[1] * v[1]) + (v[2] * v[2] + v[3] * v[3]); xr[64 * j] = v; bo[64 * j] = (u32x2){pk2(v[0], v[1]), pk2(v[2], v[3])}; }
        s2 = wave_sum(s2);
        if (lane == 0) RS[row] = rsqrtf(s2 * (1.0f / DM) + NORM_EPS);
    }
}

__device__ __forceinline__ void swa_phase(LAS unsigned char* lds, const bf16_t* Q, const bf16_t* Kb, const bf16_t* Vb, bf16_t* O, const float* sinks, int bid, int G, int tid) {
    const int lane = tid & 63, wave = __builtin_amdgcn_readfirstlane(tid >> 6), l16 = lane & 15, kg = lane >> 4, tq = (lane & 15) >> 2, tp = lane & 3;
    constexpr int KSTR = 144;
    LAS unsigned char* Ks = lds; LAS unsigned char* Vs = lds + 384 * KSTR;
    for (int unit = bid; unit < 1536; unit += G) {
        const int b = unit >> 2, kvh = unit & 3;
        int s0, nb; if (b < 256) { s0 = b & ~63; nb = 64; } else { s0 = 256 + ((b - 256) & ~15); nb = 16; }
        const int n = b - s0;
        for (int idx = tid; idx < 3072; idx += 512) {
            const int r = idx >> 3, c = idx & 7, bn = n - 1 + (r >> 7);
            u32x4 kv = (u32x4){0u, 0u, 0u, 0u}, vv = (u32x4){0u, 0u, 0u, 0u};
            if (bn >= 0 && bn < nb) { const size_t go = ((size_t)(s0 + bn) * 128 + (r & 127)) * 256 + kvh * 64 + 8 * c; kv = *(const u32x4*)(Kb + go); vv = *(const u32x4*)(Vb + go); }
            *(LAS u32x4*)(Ks + r * KSTR + c * 16) = kv; *(LAS u32x4*)(Vs + r * KSTR + c * 16) = vv;
        }
        __syncthreads();
        const int qh = kvh * 4 + (wave >> 1); const float sink = sinks[qh];
#pragma unroll 1
        for (int it = 0; it < 4; ++it) {
            const int qi = 16 * ((wave & 1) * 4 + it) + l16; const size_t qrow = (size_t)b * 128 + qi;
            bf16x8 qf[2];
#pragma unroll
            for (int kk = 0; kk < 2; ++kk) qf[kk] = *(const bf16x8*)(Q + qrow * 1024 + qh * 64 + 32 * kk + 8 * kg);
            f32x4 sc[24]; float mx = sink;
#pragma unroll
            for (int t = 0; t < 24; ++t) {
                f32x4 acc = (f32x4){0.f, 0.f, 0.f, 0.f};
#pragma unroll
                for (int kk = 0; kk < 2; ++kk) { const bf16x8 a = *(const LAS bf16x8*)(Ks + (16 * t + l16) * KSTR + (32 * kk + 8 * kg) * 2); acc = MFMA16(a, qf[kk], acc); }
                const int bn = n - 1 + (t >> 3); const bool bval = bn >= 0 && bn < nb;
#pragma unroll
                for (int j = 0; j < 4; ++j) { const int rel = 16 * t + 4 * kg + j - 128 - qi; const bool valid = bval && rel >= -128 && rel <= 128; acc[j] = valid ? acc[j] : -1e30f; mx = fmaxf(mx, acc[j]); }
                sc[t] = acc;
            }
            mx = fmaxf(mx, __shfl_xor(mx, 16)); mx = fmaxf(mx, __shfl_xor(mx, 32));
            float sum = 0.f;
#pragma unroll
            for (int t = 0; t < 24; ++t)
#pragma unroll
                for (int j = 0; j < 4; ++j) { const float p = sc[t][j] > -1e29f ? __expf(sc[t][j] - mx) : 0.f; sum += p; sc[t][j] = p; }
            sum += __shfl_xor(sum, 16); sum += __shfl_xor(sum, 32); sum += __expf(sink - mx);
            f32x4 o[4];
#pragma unroll
            for (int dt = 0; dt < 4; ++dt) o[dt] = (f32x4){0.f, 0.f, 0.f, 0.f};
#pragma unroll
            for (int u = 0; u < 12; ++u) {
                const bf16x8 pf = packp(sc[2 * u], sc[2 * u + 1]);
#pragma unroll
                for (int dt = 0; dt < 4; ++dt) {
                    const s16x4 lo = vtr(Vs + (32 * u + 4 * kg + tq) * KSTR + (16 * dt + 4 * tp) * 2), hi = vtr(Vs + (32 * u + 16 + 4 * kg + tq) * KSTR + (16 * dt + 4 * tp) * 2);
                    o[dt] = MFMA16(cat8(lo, hi), pf, o[dt]);
                }
            }
            const float inv = 1.0f / sum;
#pragma unroll
            for (int dt = 0; dt < 4; ++dt) *(u32x2*)(O + qrow * 1024 + qh * 64 + 16 * dt + 4 * kg) = (u32x2){pk2(o[dt][0] * inv, o[dt][1] * inv), pk2(o[dt][2] * inv, o[dt][3] * inv)};
        }
        __syncthreads();
    }
}

__device__ __forceinline__ void gla_pa(LAS unsigned char* lds, bf16_t* QK, bf16_t* QKB, const float* GD, float* DEC, const float* wgf, const float* bgf, const float* wgb, const float* bgb, int bid, int G, int tid) {
    LAS float* gds = (LAS float*)lds;
    const int col = tid;
    float wf[16], wb[16];
#pragma unroll
    for (int r = 0; r < 16; ++r) { wf[r] = wgf[r * 512 + col]; wb[r] = wgb[r * 512 + col]; }
    const float bf_ = bgf[col], bb_ = bgb[col];
    for (int cb = bid; cb < 384; cb += G) {
        const size_t r0 = (size_t)cb * 128;
#pragma unroll
        for (int i = 0; i < 2; ++i) { const int idx = tid + 512 * i; *(LAS f32x4*)(gds + 4 * idx) = *(const f32x4*)(GD + r0 * 32 + 4 * idx); }
        __syncthreads();
        float b = 0.f;
#pragma unroll 4
        for (int t = 127; t >= 0; --t) {
            float z = bb_;
#pragma unroll
            for (int r = 0; r < 16; ++r) z += gds[t * 32 + 16 + r] * wb[r];
            b += (fminf(z, 0.f) - __logf(1.0f + __expf(-fabsf(z)))) * 0.0625f;
            const size_t off = (r0 + t) * 1024 + col;
            const float q = bf2f(QK[off]), k = bf2f(QK[off + 512]);
            QKB[off] = (bf16_t)f2bf(q * __expf(b)); QKB[off + 512] = (bf16_t)f2bf(k * __expf(-b));
        }
        DEC[(size_t)(384 + cb) * 512 + col] = __expf(b);
        b = 0.f;
#pragma unroll 4
        for (int t = 0; t < 128; ++t) {
            float z = bf_;
#pragma unroll
            for (int r = 0; r < 16; ++r) z += gds[t * 32 + r] * wf[r];
            b += (fminf(z, 0.f) - __logf(1.0f + __expf(-fabsf(z)))) * 0.0625f;
            const size_t off = (r0 + t) * 1024 + col;
            const float q = bf2f(QK[off]), k = bf2f(QK[off + 512]);
            QK[off] = (bf16_t)f2bf(q * __expf(b)); QK[off + 512] = (bf16_t)f2bf(k * __expf(-b));
        }
        DEC[(size_t)cb * 512 + col] = __expf(b);
        __syncthreads();
    }
}
__device__ __forceinline__ void gla_pb(LAS unsigned char* lds, const bf16_t* V, const bf16_t* QK, const bf16_t* QKB, const float* DEC, bf16_t* ST, int bid, int G, int tid) {
    const int lane = tid & 63, wave = __builtin_amdgcn_readfirstlane(tid >> 6), l16 = lane & 15, kg = lane >> 4, tq = (lane & 15) >> 2, tp = lane & 3;
    constexpr int VSTR = 528, KSTR = 272;
    LAS unsigned char* Vs = lds; LAS unsigned char* KIs = lds + 128 * VSTR;
    for (int unit = bid; unit < 3072; unit += G) {
        const int dir = unit / 1536, rem = unit - dir * 1536, cb = rem >> 2, h = rem & 3;
        const bf16_t* KI = (dir ? QKB : QK) + 512 + h * 128; const size_t r0 = (size_t)cb * 128;
#pragma unroll
        for (int i = 0; i < 8; ++i) { const int idx = tid + 512 * i, r = idx >> 5, c = idx & 31; *(LAS u32x4*)(Vs + r * VSTR + c * 16) = *(const u32x4*)(V + (r0 + r) * 1024 + h * 256 + 8 * c); }
#pragma unroll
        for (int i = 0; i < 4; ++i) { const int idx = tid + 512 * i, r = idx >> 4, c = idx & 15; *(LAS u32x4*)(KIs + r * KSTR + c * 16) = *(const u32x4*)(KI + (r0 + r) * 1024 + 8 * c); }
        __syncthreads();
        f32x4 acc[8][2];
#pragma unroll
        for (int mt = 0; mt < 8; ++mt) { acc[mt][0] = (f32x4){0.f, 0.f, 0.f, 0.f}; acc[mt][1] = (f32x4){0.f, 0.f, 0.f, 0.f}; }
#pragma unroll
        for (int ks = 0; ks < 4; ++ks) {
            bf16x8 bfr[2];
#pragma unroll
            for (int nt = 0; nt < 2; ++nt) { LAS const unsigned char* p = Vs + (32 * ks + 8 * kg + tq) * VSTR + (32 * wave + 16 * nt + 4 * tp) * 2; bfr[nt] = cat8(vtr(p), vtr(p + 4 * VSTR)); }
#pragma unroll
            for (int mt = 0; mt < 8; ++mt) { LAS const unsigned char* p = KIs + (32 * ks + 8 * kg + tq) * KSTR + (16 * mt + 4 * tp) * 2; const bf16x8 afr = cat8(vtr(p), vtr(p + 4 * KSTR));
                acc[mt][0] = MFMA16(afr, bfr[0], acc[mt][0]); acc[mt][1] = MFMA16(afr, bfr[1], acc[mt][1]); }
        }
        const float* dp = DEC + (size_t)(dir * 384 + cb) * 512 + h * 128;
        bf16_t* dst = ST + (((size_t)dir * 384 + cb) * 4 + h) * 32768;
#pragma unroll
        for (int mt = 0; mt < 8; ++mt) { const int k0 = 16 * mt + 4 * kg; const f32x4 d4 = *(const f32x4*)(dp + k0);
#pragma unroll
            for (int nt = 0; nt < 2; ++nt) { const int v = 32 * wave + 16 * nt + l16; const f32x4 a = acc[mt][nt] * d4;
                *(u32x2*)(dst + (size_t)v * 128 + k0) = (u32x2){pk2(a[0], a[1]), pk2(a[2], a[3])}; } }
        __syncthreads();
    }
}
__device__ __forceinline__ void gla_pc(bf16_t* ST, const float* DEC, int bid, int G, int tid) {
    for (int vw = bid; vw < 768; vw += G) {
        const int item = vw * 512 + tid;
        int sd, e, nchunk, cb0;
        if (item < 131072) { sd = item >> 14; e = item & 16383; nchunk = 64; cb0 = (sd >> 1) * 64; }
        else { const int i2 = item - 131072; sd = i2 >> 14; e = i2 & 16383; nchunk = 16; cb0 = 256 + (sd >> 1) * 16; }
        const int dir = sd & 1, h = e >> 12, k0 = (e & 15) * 8;
        bf16_t* base = ST + (size_t)dir * 384 * 131072 + (size_t)e * 8;
        const float* dbase = DEC + (size_t)dir * 384 * 512 + h * 128 + k0;
        float S[8];
#pragma unroll
        for (int i = 0; i < 8; ++i) S[i] = 0.f;
        for (int c4 = 0; c4 < nchunk; c4 += 4) {
            u32x4 uu[4]; f32x4 d0[4], d1[4];
#pragma unroll
            for (int i = 0; i < 4; ++i) { const int cb = dir ? cb0 + nchunk - 1 - (c4 + i) : cb0 + c4 + i;
                uu[i] = *(const u32x4*)(base + (size_t)cb * 131072); d0[i] = *(const f32x4*)(dbase + (size_t)cb * 512); d1[i] = *(const f32x4*)(dbase + (size_t)cb * 512 + 4); }
#pragma unroll
            for (int i = 0; i < 4; ++i) { const int cb = dir ? cb0 + nchunk - 1 - (c4 + i) : cb0 + c4 + i;
                u32x4 w; w.x = pk2(S[0], S[1]); w.y = pk2(S[2], S[3]); w.z = pk2(S[4], S[5]); w.w = pk2(S[6], S[7]);
                *(u32x4*)(base + (size_t)cb * 131072) = w;
                S[0] = d0[i][0] * S[0] + bflo(uu[i].x); S[1] = d0[i][1] * S[1] + bfhi(uu[i].x); S[2] = d0[i][2] * S[2] + bflo(uu[i].y); S[3] = d0[i][3] * S[3] + bfhi(uu[i].y);
                S[4] = d1[i][0] * S[4] + bflo(uu[i].z); S[5] = d1[i][1] * S[5] + bfhi(uu[i].z); S[6] = d1[i][2] * S[6] + bflo(uu[i].w); S[7] = d1[i][3] * S[7] + bfhi(uu[i].w); }
        }
    }
}
__device__ __forceinline__ void gla_pd(LAS unsigned char* lds, const bf16_t* QK, const bf16_t* QKB, const bf16_t* V, bf16_t* R, const bf16_t* ST, const float* onorm, int bid, int G, int tid) {
    const int lane = tid & 63, wave = __builtin_amdgcn_readfirstlane(tid >> 6), l16 = lane & 15, kg = lane >> 4, tq = (lane & 15) >> 2, tp = lane & 3;
    constexpr int VSTR = 528, SSTR = 272;
    LAS unsigned char* Vs = lds; LAS unsigned char* STs = lds + 128 * VSTR;
    for (int unit = bid; unit < 1536; unit += G) {
        const int cb = unit >> 2, h = unit & 3; const size_t r0 = (size_t)cb * 128;
        __syncthreads();
#pragma unroll
        for (int i = 0; i < 8; ++i) { const int idx = tid + 512 * i, r = idx >> 5, c = idx & 31; *(LAS u32x4*)(Vs + r * VSTR + c * 16) = *(const u32x4*)(V + (r0 + r) * 1024 + h * 256 + 8 * c); }
        const int t_loc = 16 * wave + l16; const size_t trow = r0 + t_loc;
        f32x4 o[16], Pm[8];
#pragma unroll
        for (int i = 0; i < 16; ++i) o[i] = (f32x4){0.f, 0.f, 0.f, 0.f};
#pragma unroll
        for (int i = 0; i < 8; ++i) Pm[i] = (f32x4){0.f, 0.f, 0.f, 0.f};
#pragma unroll 1
        for (int dir = 0; dir < 2; ++dir) {
            const bf16_t* QD = (dir ? QKB : QK) + h * 128; const bf16_t* KI = QD + 512;
            const bf16_t* src = ST + (((size_t)dir * 384 + cb) * 4 + h) * 32768;
#pragma unroll
            for (int i = 0; i < 4; ++i) { const int idx = tid + 512 * i, r = idx >> 4, c = idx & 15; *(LAS u32x4*)(STs + r * SSTR + c * 16) = *(const u32x4*)(KI + (r0 + r) * 1024 + 8 * c); }
            bf16x8 qf[4];
#pragma unroll
            for (int ks = 0; ks < 4; ++ks) qf[ks] = *(const bf16x8*)(QD + trow * 1024 + 32 * ks + 8 * kg);
            __syncthreads();
#pragma unroll
            for (int st = 0; st < 8; ++st) {
                f32x4 acc = (f32x4){0.f, 0.f, 0.f, 0.f};
#pragma unroll
                for (int ks = 0; ks < 4; ++ks) { const bf16x8 a = *(const LAS bf16x8*)(STs + (16 * st + l16) * SSTR + (32 * ks + 8 * kg) * 2); acc = MFMA16(a, qf[ks], acc); }
#pragma unroll
                for (int j = 0; j < 4; ++j) { const int s = 16 * st + 4 * kg + j; const bool keep = dir ? (s >= t_loc) : (s <= t_loc); Pm[st][j] += keep ? acc[j] : 0.f; }
                if (st & 1) asm volatile("" ::: "memory");
            }
            __syncthreads();
#pragma unroll
            for (int i = 0; i < 8; ++i) { const int idx = tid + 512 * i, r = idx >> 4, c = idx & 15; *(LAS u32x4*)(STs + r * SSTR + c * 16) = *(const u32x4*)(src + (size_t)r * 128 + 8 * c); }
            __syncthreads();
#pragma unroll
            for (int vt = 0; vt < 16; ++vt) {
#pragma unroll
                for (int ks = 0; ks < 4; ++ks) { const bf16x8 a = *(const LAS bf16x8*)(STs + (16 * vt + l16) * SSTR + (32 * ks + 8 * kg) * 2); o[vt] = MFMA16(a, qf[ks], o[vt]); }
                if (vt & 1) asm volatile("" ::: "memory");
            }
            __syncthreads();
        }
#pragma unroll
        for (int u = 0; u < 4; ++u) {
            const bf16x8 pf = packp(Pm[2 * u], Pm[2 * u + 1]);
#pragma unroll
            for (int vt = 0; vt < 16; ++vt) {
                const s16x4 lo = vtr(Vs + (32 * u + 4 * kg + tq) * VSTR + (16 * vt + 4 * tp) * 2), hi = vtr(Vs + (32 * u + 16 + 4 * kg + tq) * VSTR + (16 * vt + 4 * tp) * 2);
                o[vt] = MFMA16(cat8(lo, hi), pf, o[vt]);
                if ((vt & 3) == 3) asm volatile("" ::: "memory");
            }
        }
        float ss = 0.f;
#pragma unroll
        for (int vt = 0; vt < 16; ++vt) ss += (o[vt][0] * o[vt][0] + o[vt][1] * o[vt][1]) + (o[vt][2] * o[vt][2] + o[vt][3] * o[vt][3]);
        ss += __shfl_xor(ss, 16); ss += __shfl_xor(ss, 32);
        const float rs = rsqrtf(ss * (1.0f / 256.0f) + NORM_EPS);
#pragma unroll
        for (int vt = 0; vt < 16; ++vt) { const int vcol = h * 256 + 16 * vt + 4 * kg; const f32x4 gn = *(const f32x4*)(onorm + vcol);
            u32x2* yp = (u32x2*)(R + trow * 1024 + vcol); const u32x2 rw = *yp;
            const f32x4 y = o[vt] * rs * gn * (f32x4){bflo(rw.x), bfhi(rw.x), bflo(rw.y), bfhi(rw.y)};
            *yp = (u32x2){pk2(y[0], y[1]), pk2(y[2], y[3])};
            if ((vt & 3) == 3) asm volatile("" ::: "memory"); }
    }
}

struct Args { const float* in[15]; float* out; unsigned char* ws; float inv_freq[8]; int ph_lo, ph_hi, coop, pad; };
constexpr int PH_PER_LAYER = 13, N_PHASES = 1 + NLAYER * PH_PER_LAYER;
__host__ __device__ inline bool phase_empty(int ph) { if (ph == 0) return false; const int L = (ph - 1) / PH_PER_LAYER, sub = (ph - 1) % PH_PER_LAYER; return (L & 1) && sub >= 5 && sub <= 7; }

__global__ void __launch_bounds__(NWAVES * 64, 2) fwd_kernel(Args a) {
    extern __shared__ __attribute__((aligned(16))) unsigned char lds_raw[];
    LAS unsigned char* lds = (LAS unsigned char*)lds_raw;
    const int G = gridDim.x, bid = blockIdx.x;
    bool first = true;
    for (int ph = a.ph_lo; ph < a.ph_hi; ++ph) {
        if (phase_empty(ph)) continue;
        if (!first && a.coop) cg::this_grid().sync();
        first = false;
        int tid = threadIdx.x; asm volatile("" : "+v"(tid));
        const int lane = tid & 63, wave = __builtin_amdgcn_readfirstlane(tid >> 6), gw = bid * NWAVES + wave, NGW = G * NWAVES;
        unsigned char* ws = a.ws; asm volatile("" : "+s"(ws));
        Ptrs P; P.xp = a.in[0]; P.xs = a.in[1]; P.norm_g = a.in[2]; P.w1 = a.in[3]; P.w2 = a.in[4]; P.gla_in = a.in[5]; P.wgf = a.in[6]; P.bgf = a.in[7]; P.wgb = a.in[8]; P.bgb = a.in[9];
        P.onorm = a.in[10]; P.gla_out = a.in[11]; P.swa_in = a.in[12]; P.sinks = a.in[13]; P.swa_out = a.in[14]; P.out = a.out; P.ws = ws;
        bf16_t* XB = (bf16_t*)(ws + WS_XB); bf16_t* HB = (bf16_t*)(ws + WS_H); const float* RS = (const float*)(ws + WS_RS);
        if (ph == 0) {
            init_rows(P, gw, NGW, lane);
            float* rope = (float*)(ws + WS_ROPE);
            for (int i = bid * 512 + tid; i < 8192 * 8; i += G * 512) { const int pos = i >> 3, f = i & 7;
                double rev = (double)pos * (double)a.inv_freq[f] * 0.15915494309189535; rev -= floor(rev);
                rope[pos * 16 + f] = __builtin_amdgcn_cosf((float)rev); rope[pos * 16 + 8 + f] = __builtin_amdgcn_sinf((float)rev); }
            convert_layer(P, 0, lds, gw, NGW, wave, lane);
            continue;
        }
        const int L = (ph - 1) / PH_PER_LAYER, sub = (ph - 1) % PH_PER_LAYER; const bool gla = (L & 1) == 0; const int j = L >> 1;
        const float* g = P.norm_g + (size_t)L * 6 * 1024;
        switch (sub) {
        case 0: case 10: {
            pg8::Gemm gm{XB, (const bf16_t*)(ws + (sub == 0 ? WS_W1A : WS_W1B)), T_TOK, 2 * DFF, DM}; pg8::StaticOrder S; S.init(T_TOK, 2 * DFF, G, bid);
            pg8::EpiSwiGLU E{(bf16_t*)(ws + WS_B), RS};
            pg8::gemm_phase<pg8::EpiSwiGLU, pg8::StaticOrder, true, true>(lds, gm, S, E, tid);
        } break;
        case 1: case 11: {
            pg8::Gemm gm{(const bf16_t*)(ws + WS_B), (const bf16_t*)(ws + (sub == 1 ? WS_W2A : WS_W2B)), T_TOK, DM, DFF}; pg8::StaticOrder S; S.init(T_TOK, DM, G, bid);
            pg8::EpiPlain E{HB, DM};
            pg8::gemm_phase<pg8::EpiPlain, pg8::StaticOrder, true, true>(lds, gm, S, E, tid);
        } break;
        case 2: nr_rows(P, g + 1 * 1024, 0.5f, gw, NGW, lane); break;
        case 9: nr_rows(P, g + 3 * 1024, 1.0f, gw, NGW, lane); break;
        case 12: nr_rows(P, g + 5 * 1024, 0.5f, gw, NGW, lane); if (L + 1 < NLAYER) convert_layer(P, L + 1, lds, gw, NGW, wave, lane); break;
        case 3: {
            if (gla) {
                pg8::Gemm gm{XB, (const bf16_t*)(ws + WS_WMI), T_TOK, GLA_NP, DM}; pg8::StaticOrder S; S.init(T_TOK, GLA_NP, G, bid);
                pg8::EpiGlaIn E{ws, RS};
                pg8::gemm_phase<pg8::EpiGlaIn, pg8::StaticOrder, true, true>(lds, gm, S, E, tid);
            } else {
                pg8::Gemm gm{XB, (const bf16_t*)(ws + WS_WMI), T_TOK, SWA_N, DM}; pg8::StaticOrder S; S.init(T_TOK, SWA_N, G, bid);
                pg8::EpiSwaIn E{ws, RS};
                pg8::gemm_phase<pg8::EpiSwaIn, pg8::StaticOrder, true, true>(lds, gm, S, E, tid);
            }
        } break;
        case 4:
            if (gla) gla_pa(lds, HB, XB, (const float*)(ws + WS_GD), (float*)(ws + WS_DEC), P.wgf + (size_t)j * 16 * 512, P.bgf + j * 512, P.wgb + (size_t)j * 16 * 512, P.bgb + j * 512, bid, G, tid);
            else swa_phase(lds, (const bf16_t*)(ws + WS_SQ), (const bf16_t*)(ws + WS_SK), (const bf16_t*)(ws + WS_SV), (bf16_t*)(ws + WS_SO), P.sinks + j * 16, bid, G, tid);
            break;
        case 5: gla_pb(lds, (const bf16_t*)(ws + WS_GV), HB, XB, (const float*)(ws + WS_DEC), (bf16_t*)(ws + WS_ST), bid, G, tid); break;
        case 6: gla_pc((bf16_t*)(ws + WS_ST), (const float*)(ws + WS_DEC), bid, G, tid); break;
        case 7: gla_pd(lds, HB, XB, (const bf16_t*)(ws + WS_GV), (bf16_t*)(ws + WS_GR), (const bf16_t*)(ws + WS_ST), P.onorm + j * 1024, bid, G, tid); break;
        case 8: {
            pg8::Gemm gm{(const bf16_t*)(ws + (gla ? WS_GR : WS_SO)), (const bf16_t*)(ws + WS_WMO), T_TOK, DM, DM}; pg8::StaticOrder S; S.init(T_TOK, DM, G, bid);
            pg8::EpiPlain E{HB, DM};
            pg8::gemm_phase<pg8::EpiPlain, pg8::StaticOrder, true, true>(lds, gm, S, E, tid);
        } break;
        default: break;
        }
    }
}

extern "C" void kernel_launch(void* const* d_in, const int* in_sizes, int n_in, void* d_out, int out_size, void* d_ws, size_t ws_size, hipStream_t stream) {
    static int grid = 0;
    if (grid == 0) {
        if (n_in != 15 || out_size != T_TOK * DM || ws_size < WS_END) { fprintf(stderr, "kernel_launch: unexpected shapes (n_in %d out %d ws %zu, need %zu); nothing launched\n", n_in, out_size, ws_size, (size_t)WS_END); grid = -1; return; }
        int dev = 0, cus = 0, per_cu = 0;
        if (hipGetDevice(&dev) != hipSuccess || hipDeviceGetAttribute(&cus, hipDeviceAttributeMultiprocessorCount, dev) != hipSuccess) { grid = -1; return; }
        if (hipFuncSetAttribute((const void*)fwd_kernel, hipFuncAttributeMaxDynamicSharedMemorySize, LDS_BYTES) != hipSuccess) { fprintf(stderr, "kernel_launch: hipFuncSetAttribute failed\n"); grid = -1; return; }
        if (hipOccupancyMaxActiveBlocksPerMultiprocessor(&per_cu, (const void*)fwd_kernel, NWAVES * 64, LDS_BYTES) != hipSuccess || per_cu < 1) { fprintf(stderr, "kernel_launch: occupancy query says %d\n", per_cu); per_cu = 1; }
        (void)hipGetLastError();
        grid = cus * per_cu;
    }
    if (grid < 0) return;
    Args a{};
    for (int i = 0; i < 15; ++i) a.in[i] = (const float*)d_in[i];
    a.out = (float*)d_out; a.ws = (unsigned char*)d_ws;
    for (int i = 0; i < 8; ++i) a.inv_freq[i] = (float)std::pow(500000.0, -(double)i / 8.0);
#if MK_MULTI_LAUNCH
    a.coop = 0;
    for (int ph = 0; ph < N_PHASES; ++ph) {
        if (phase_empty(ph)) continue;
        a.ph_lo = ph; a.ph_hi = ph + 1;
        hipLaunchKernelGGL(fwd_kernel, dim3(grid), dim3(NWAVES * 64), LDS_BYTES, stream, a);
    }
#else
    a.coop = 1; a.ph_lo = 0; a.ph_hi = N_PHASES;
    void* args[] = {&a};
    hipError_t e = hipLaunchCooperativeKernel((const void*)fwd_kernel, dim3(grid), dim3(NWAVES * 64), args, LDS_BYTES, stream);
    if (e != hipSuccess) fprintf(stderr, "kernel_launch: cooperative launch failed: %s (grid %d)\n", hipGetErrorString(e), grid);
#endif
}
```

```cpp
#include <hip/hip_runtime.h>
#include <hip/hip_cooperative_groups.h>
#include <cstdio>
#include <cstdint>
#include <cmath>
namespace cg = cooperative_groups;
#ifndef MK_MULTI_LAUNCH
#define MK_MULTI_LAUNCH 0
#endif
constexpr size_t MiB = 1u << 20;
constexpr size_t WS_ROPE = 0, WS_RS = 1 * MiB, WS_CTL = 2 * MiB;
constexpr size_t WS_W1A = 4 * MiB, WS_W1B = 15 * MiB, WS_W2A = 26 * MiB, WS_W2B = 32 * MiB, WS_WMI = 38 * MiB, WS_WMO = 45 * MiB;
constexpr size_t WS_XB = 48 * MiB;
constexpr size_t WS_H = 144 * MiB;
constexpr size_t WS_B = 240 * MiB;
constexpr size_t WS_GV = 240 * MiB, WS_GR = 336 * MiB, WS_GD = 432 * MiB, WS_DEC = 438 * MiB, WS_ST = 440 * MiB;
constexpr size_t WS_SQ = 240 * MiB, WS_SK = 336 * MiB, WS_SV = 360 * MiB, WS_SO = 384 * MiB;
constexpr size_t WS_END = 632 * MiB;

namespace pg8 {
#define PG8_LAS __attribute__((address_space(3)))
typedef unsigned short bf16_t;
typedef short bf16x8 __attribute__((ext_vector_type(8)));
typedef float f32x4 __attribute__((ext_vector_type(4)));
typedef unsigned u32x4 __attribute__((ext_vector_type(4)));
constexpr int BM = 256, BK = 64, HALF = 128, HTB = HALF * BK * 2  , STAGE_BYTES = 8 * HTB, NXCD = 8, WGM = 8;

__host__ __device__ __forceinline__ int lds_byte(int r, int c) { const int st = (r >> 4) * 2 + (c >> 5), rr = r & 15, cc = c & 31, ob = rr * 64 + cc * 2; return st * 1024 + (ob ^ (((ob >> 9) & 1) << 5)); }
__host__ __device__ __forceinline__ void stage_rc(int b, int& R, int& C) { const int st = b / 1024, sb = b % 1024, swz = sb ^ (((sb >> 9) & 1) << 5); R = (st >> 1) * 16 + swz / 64; C = (st & 1) * 32 + (swz % 64) / 2; }
__host__ __device__ __forceinline__ int perm32(int rho) { const int n = rho >> 4, i = rho & 15; return 8 * (i >> 2) + 4 * n + (i & 3); }

struct Unit { int pm, pn; };
struct Gemm { const bf16_t* A; const bf16_t* Bt; int M, N, K; };

struct StaticOrder {
    int nM, nN, nwg, G, c;
    __host__ __device__ void init(int M, int N, int G_, int c_) { nM = M / BM; nN = N / BM; nwg = nM * nN; G = G_; c = c_; }
    __host__ __device__ bool next(int i, Unit& u) const {
        const long L = (long)i * G + c; if (L >= nwg) return false;
        int wgid = (int)L; { const int q = nwg / NXCD, r = nwg % NXCD, xcd = wgid % NXCD, off = wgid / NXCD; wgid = (xcd < r ? xcd * (q + 1) : r * (q + 1) + (xcd - r) * q) + off; }
        const int nig = WGM * nN, gid = wgid / nig, fm = gid * WGM, gsz = (nM - fm) < WGM ? (nM - fm) : WGM;
        u.pm = fm + ((wgid % nig) % gsz); u.pn = (wgid % nig) / gsz; return true;
    }
    __device__ __forceinline__ void a_ready(const Unit&) const {}
    __device__ __forceinline__ void done(const Unit&) const {}
};
__device__ __forceinline__ unsigned cvt_pk_bf16(float lo, float hi) { unsigned r; asm volatile("v_cvt_pk_bf16_f32 %0, %1, %2" : "=v"(r) : "v"(lo), "v"(hi)); return r; }
typedef float f32x2 __attribute__((ext_vector_type(2)));
typedef unsigned u32x2 __attribute__((ext_vector_type(2)));
__device__ __forceinline__ float silu_f(float v) { return v * __builtin_amdgcn_rcpf(1.0f + __expf(-v)); }
__device__ __forceinline__ f32x4 silu4(f32x4 v) { return (f32x4){silu_f(v[0]), silu_f(v[1]), silu_f(v[2]), silu_f(v[3])}; }
__device__ __forceinline__ u32x4 pack8(f32x4 a, f32x4 b) { u32x4 w; w.x = cvt_pk_bf16(a[0], a[1]); w.y = cvt_pk_bf16(a[2], a[3]); w.z = cvt_pk_bf16(b[0], b[1]); w.w = cvt_pk_bf16(b[2], b[3]); return w; }

struct EpiPlain {
    static constexpr bool PERM = true, AFTER_DRAIN = false;
    bf16_t* O; int ldc;
    __device__ __forceinline__ void operator()(const f32x4 (&acc)[2][2][4][2], const Unit& u, int wr, int wc, int fr, int fq) const {
        const int row0 = u.pm * BM + wr * 64 + fr, col0 = u.pn * BM + wc * 32 + 8 * fq;
#pragma unroll
        for (int ai = 0; ai < 2; ++ai)
#pragma unroll
            for (int m = 0; m < 4; ++m) { bf16_t* rowp = O + (size_t)(row0 + ai * HALF + m * 16) * ldc + col0;
#pragma unroll
                for (int bj = 0; bj < 2; ++bj) *(u32x4*)(rowp + bj * HALF) = pack8(acc[ai][bj][m][0], acc[ai][bj][m][1]); }
    }
};
struct EpiSwiGLU {
    static constexpr bool PERM = true, AFTER_DRAIN = false;
    bf16_t* O; const float* rs;
    __device__ __forceinline__ void operator()(const f32x4 (&acc)[2][2][4][2], const Unit& u, int wr, int wc, int fr, int fq) const {
        const int row0 = u.pm * BM + wr * 64 + fr, col0 = u.pn * HALF + wc * 32 + 8 * fq;
#pragma unroll
        for (int ai = 0; ai < 2; ++ai)
#pragma unroll
            for (int m = 0; m < 4; ++m) { const int row = row0 + ai * HALF + m * 16; const float r = rs[row];
                const f32x4 g0 = acc[ai][0][m][0] * r, g1 = acc[ai][0][m][1] * r, u0 = acc[ai][1][m][0] * r, u1 = acc[ai][1][m][1] * r;
                *(u32x4*)(O + (size_t)row * 2816 + col0) = pack8(silu4(g0) * u0, silu4(g1) * u1); }
    }
};
struct EpiGlaIn {
    static constexpr bool PERM = true, AFTER_DRAIN = false;
    unsigned char* ws; const float* rs;
    __device__ __forceinline__ void operator()(const f32x4 (&acc)[2][2][4][2], const Unit& u, int wr, int wc, int fr, int fq) const {
        const int row0 = u.pm * BM + wr * 64 + fr, pn = u.pn;
        if (pn == 12) {
            if (wc == 0) {
#pragma unroll
                for (int ai = 0; ai < 2; ++ai)
#pragma unroll
                    for (int m = 0; m < 4; ++m) { const int row = row0 + ai * HALF + m * 16; const float r = rs[row]; float* gp = (float*)(ws + WS_GD) + (size_t)row * 32 + 8 * fq;
                        *(f32x4*)(gp) = acc[ai][0][m][0] * r; *(f32x4*)(gp + 4) = acc[ai][0][m][1] * r; }
            }
            return;
        }
        bf16_t* base = (bf16_t*)(ws + (pn < 4 ? WS_H : (pn < 8 ? WS_GV : WS_GR)));
        const int col0 = (pn & 3) * BM + wc * 32 + 8 * fq;
        const float sc = pn < 2 ? 0.08838834764831845f : 1.0f;
#pragma unroll
        for (int ai = 0; ai < 2; ++ai)
#pragma unroll
            for (int m = 0; m < 4; ++m) { const int row = row0 + ai * HALF + m * 16; const float r = rs[row] * sc; bf16_t* rowp = base + (size_t)row * 1024 + col0;
#pragma unroll
                for (int bj = 0; bj < 2; ++bj) { f32x4 v0 = acc[ai][bj][m][0] * r, v1 = acc[ai][bj][m][1] * r;
                    if (pn >= 8) { v0 = silu4(v0); v1 = silu4(v1); }
                    *(u32x4*)(rowp + bj * HALF) = pack8(v0, v1); } }
    }
};
struct EpiSwaIn {
    static constexpr bool PERM = true, AFTER_DRAIN = false;
    unsigned char* ws; const float* rs;
    __device__ __forceinline__ void operator()(const f32x4 (&acc)[2][2][4][2], const Unit& u, int wr, int wc, int fr, int fq) const {
        const int row0 = u.pm * BM + wr * 64 + fr, pn = u.pn;
        bf16_t* base = (bf16_t*)(ws + (pn < 4 ? WS_SQ : (pn == 4 ? WS_SK : WS_SV))); const int ldc = pn < 4 ? 1024 : 256;
        const int col0 = (pn < 4 ? pn * BM : 0) + wc * 32 + 8 * fq;
        const bool do_rope = (pn <= 4) && ((wc & 1) == 0);
        const float qs = pn < 4 ? 0.125f : 1.0f;
#pragma unroll
        for (int ai = 0; ai < 2; ++ai)
#pragma unroll
            for (int m = 0; m < 4; ++m) { const int row = row0 + ai * HALF + m * 16; const float r = rs[row]; bf16_t* rowp = base + (size_t)row * ldc + col0;
                const int pos = row < 32768 ? (row & 8191) : (row & 2047);
#pragma unroll
                for (int bj = 0; bj < 2; ++bj) { f32x4 v0 = acc[ai][bj][m][0] * r, v1 = acc[ai][bj][m][1] * r;
                    if (do_rope) {
                        f32x4 p0, p1;
#pragma unroll
                        for (int j = 0; j < 4; ++j) { p0[j] = __shfl_xor(v0[j], 16); p1[j] = __shfl_xor(v1[j], 16); }
                        if (fq < 2) {
                            const float* rp = (const float*)(ws + WS_ROPE) + (size_t)pos * 16;
                            const f32x4 c0 = *(const f32x4*)(rp), c1 = *(const f32x4*)(rp + 4), s0 = *(const f32x4*)(rp + 8), s1 = *(const f32x4*)(rp + 12);
                            if (fq == 0) { v0 = v0 * c0 - p0 * s0; v1 = v1 * c1 - p1 * s1; }
                            else         { v0 = v0 * c0 + p0 * s0; v1 = v1 * c1 + p1 * s1; }
                        }
                    }
                    v0 = v0 * qs; v1 = v1 * qs;
                    *(u32x4*)(rowp + bj * HALF) = pack8(v0, v1); } }
    }
};
template <class Epi, class Sched, bool ALIGN_EPI = false, bool SP2 = false>
__device__ __forceinline__ void gemm_phase(PG8_LAS unsigned char* lds, const Gemm g, const Sched& S, const Epi& E, int tid_in) {
    const int tid = tid_in, wid = __builtin_amdgcn_readfirstlane(tid >> 6), lane = tid & 63, wr = wid >> 2, wc = wid & 3, fr = lane & 15, fq = lane >> 4;
    const int K = g.K, nt = K / BK;
    unsigned voffA[2], voffB[2];
#pragma unroll
    for (int i = 0; i < 2; ++i) { int R, C; stage_rc(tid * 16 + i * 8192, R, C); const int Rb = Epi::PERM ? ((R & ~31) + perm32(R & 31)) : R;
        voffA[i] = (unsigned)(R * K + C) * 2u; voffB[i] = (unsigned)(Rb * K + C) * 2u; }
    const size_t kstep = (size_t)(BK * 2);
    const size_t hstep = (size_t)HALF * K * 2;
    const size_t tstep = 2 * hstep;
    const unsigned ldsw = (unsigned)wid * 1024u;
    const int aoff = lds_byte(wr * 64 + fr, fq * 8), boff = lds_byte(wc * 32 + fr, fq * 8);
#define PG8_SA(b, h) (((b) * 2 + (h)) * HTB)
#define PG8_SB(b, h) ((4 + (b) * 2 + (h)) * HTB)
#define PG8_STAGE(bufoff, gbase, voff) do { _Pragma("unroll") for (int _i = 0; _i < 2; ++_i) \
        __builtin_amdgcn_global_load_lds((const unsigned*)((const char*)(gbase) + (voff)[_i]), (PG8_LAS unsigned*)(lds + (bufoff) + ldsw + _i * 8192), 16, 0, 0); } while (0)
#define PG8_LDA(dst, b, h) do { _Pragma("unroll") for (int m = 0; m < 4; ++m) _Pragma("unroll") for (int k = 0; k < 2; ++k) dst[m][k] = *(const PG8_LAS bf16x8*)(lds + PG8_SA(b, h) + aoff + m * 2048 + k * 1024); } while (0)
#define PG8_LDB(dst, b, h) do { _Pragma("unroll") for (int n = 0; n < 2; ++n) _Pragma("unroll") for (int k = 0; k < 2; ++k) dst[n][k] = *(const PG8_LAS bf16x8*)(lds + PG8_SB(b, h) + boff + n * 2048 + k * 1024); } while (0)
#define PG8_MMA(ai, bj, At, Bt) do { __builtin_amdgcn_s_setprio(1); _Pragma("unroll") for (int m = 0; m < 4; ++m) _Pragma("unroll") for (int n = 0; n < 2; ++n) _Pragma("unroll") for (int k = 0; k < 2; ++k) \
        acc[ai][bj][m][n] = __builtin_amdgcn_mfma_f32_16x16x32_bf16(Bt[n][k], At[m][k], acc[ai][bj][m][n], 0, 0, 0); __builtin_amdgcn_s_setprio(0); } while (0)
#define PG8_WAIT_V(n) asm volatile("s_waitcnt vmcnt(" #n ")" ::: "memory")
#define PG8_WAIT_L(n) asm volatile("s_waitcnt lgkmcnt(" #n ")" ::: "memory")
#define PG8_BAR __builtin_amdgcn_s_barrier()
#define PG8_SCHED __builtin_amdgcn_sched_barrier(0)
    Unit cur, nxt; int ui = 0;
    if (!S.next(0, cur)) return;
    f32x4 acc[2][2][4][2];
#pragma unroll
    for (int a = 0; a < 2; ++a)
#pragma unroll
        for (int b = 0; b < 2; ++b)
#pragma unroll
            for (int m = 0; m < 4; ++m)
#pragma unroll
                for (int n = 0; n < 2; ++n) acc[a][b][m][n] = (f32x4){0.f, 0.f, 0.f, 0.f};
    bf16x8 At[4][2], B0[2][2], B1[2][2];
    const char* cA = (const char*)g.A + (size_t)cur.pm * tstep; const char* cB = (const char*)g.Bt + (size_t)cur.pn * tstep;
    S.a_ready(cur);
    if constexpr (SP2) {
        PG8_STAGE(PG8_SB(0, 0), cB, voffB); PG8_STAGE(PG8_SB(0, 1), cB + hstep, voffB); PG8_STAGE(PG8_SA(0, 0), cA, voffA); PG8_STAGE(PG8_SA(0, 1), cA + hstep, voffA);
        if (wr == 1) PG8_BAR;
        PG8_WAIT_V(2); PG8_BAR;
        PG8_STAGE(PG8_SB(1, 0), cB + kstep, voffB); PG8_STAGE(PG8_SA(1, 0), cA + kstep, voffA); PG8_STAGE(PG8_SB(1, 1), cB + hstep + kstep, voffB);
        PG8_WAIT_V(6); PG8_BAR;
    } else {
        PG8_STAGE(PG8_SB(0, 0), cB, voffB); PG8_STAGE(PG8_SA(0, 0), cA, voffA); PG8_STAGE(PG8_SB(0, 1), cB + hstep, voffB); PG8_STAGE(PG8_SA(0, 1), cA + hstep, voffA);
        if (wr == 1) PG8_BAR;
        PG8_WAIT_V(4); PG8_BAR;
        PG8_STAGE(PG8_SB(1, 0), cB + kstep, voffB); PG8_STAGE(PG8_SA(1, 0), cA + kstep, voffA); PG8_STAGE(PG8_SB(1, 1), cB + hstep + kstep, voffB);
        PG8_WAIT_V(6); PG8_BAR;
    }
    for (;;) {
        const bool has_next = S.next(ui + 1, nxt);
        const char* nA = has_next ? (const char*)g.A + (size_t)nxt.pm * tstep : cA; const char* nB = has_next ? (const char*)g.Bt + (size_t)nxt.pn * tstep : cB;
        for (int t = 0; t < nt; t += 2) {
            const bool last = (t == nt - 2);
            const char* a1 = cA + (size_t)(t + 1) * kstep;
            const char* a2 = last ? nA : cA + (size_t)(t + 2) * kstep; const char* b2 = last ? nB : cB + (size_t)(t + 2) * kstep;
            const char* a3 = a2 + kstep; const char* b3 = b2 + kstep;
            if (last && has_next) S.a_ready(nxt);
            if constexpr (SP2) {
            PG8_LDB(B0, 0, 0); PG8_LDB(B1, 0, 1); PG8_SCHED; PG8_LDA(At, 0, 0); PG8_STAGE(PG8_SA(1, 1), a1 + hstep, voffA);
            PG8_WAIT_V(8); PG8_WAIT_L(0); PG8_BAR; PG8_MMA(0, 0, At, B0); PG8_MMA(0, 1, At, B1); PG8_BAR; PG8_SCHED;
            PG8_LDA(At, 0, 1); PG8_STAGE(PG8_SB(0, 0), b2, voffB); PG8_STAGE(PG8_SB(0, 1), b2 + hstep, voffB); PG8_STAGE(PG8_SA(0, 0), a2, voffA);
            PG8_WAIT_V(8); PG8_WAIT_L(0); PG8_BAR; PG8_MMA(1, 0, At, B0); PG8_MMA(1, 1, At, B1); PG8_BAR; PG8_SCHED;
            PG8_LDB(B0, 1, 0); PG8_LDB(B1, 1, 1); PG8_SCHED; PG8_LDA(At, 1, 0); PG8_STAGE(PG8_SA(0, 1), a2 + hstep, voffA);
            PG8_WAIT_V(8); PG8_WAIT_L(0); PG8_BAR; PG8_MMA(0, 0, At, B0); PG8_MMA(0, 1, At, B1); PG8_BAR; PG8_SCHED;
            PG8_LDA(At, 1, 1); PG8_STAGE(PG8_SB(1, 0), b3, voffB); PG8_STAGE(PG8_SB(1, 1), b3 + hstep, voffB); PG8_STAGE(PG8_SA(1, 0), a3, voffA);
            PG8_WAIT_V(8); PG8_WAIT_L(0); PG8_BAR; PG8_MMA(1, 0, At, B0); PG8_MMA(1, 1, At, B1); PG8_BAR; PG8_SCHED;
            } else {
            PG8_LDB(B0, 0, 0); PG8_SCHED; PG8_LDA(At, 0, 0); PG8_STAGE(PG8_SA(1, 1), a1 + hstep, voffA);
            PG8_WAIT_L(8); PG8_BAR; PG8_WAIT_L(0); PG8_MMA(0, 0, At, B0); PG8_BAR; PG8_SCHED;
            PG8_LDB(B1, 0, 1); PG8_STAGE(PG8_SB(0, 0), b2, voffB);
            PG8_BAR; PG8_WAIT_L(0); PG8_MMA(0, 1, At, B1); PG8_BAR;
            PG8_LDA(At, 0, 1); PG8_STAGE(PG8_SA(0, 0), a2, voffA);
            PG8_BAR; PG8_WAIT_L(0); PG8_MMA(1, 0, At, B0); PG8_BAR; PG8_SCHED;
            PG8_STAGE(PG8_SB(0, 1), b2 + hstep, voffB);
            PG8_WAIT_V(6); PG8_BAR; PG8_MMA(1, 1, At, B1); PG8_BAR;
            PG8_LDB(B0, 1, 0); PG8_SCHED; PG8_LDA(At, 1, 0); PG8_STAGE(PG8_SA(0, 1), a2 + hstep, voffA);
            PG8_WAIT_L(8); PG8_BAR; PG8_WAIT_L(0); PG8_MMA(0, 0, At, B0); PG8_BAR; PG8_SCHED;
            PG8_LDB(B1, 1, 1); PG8_STAGE(PG8_SB(1, 0), b3, voffB);
            PG8_BAR; PG8_WAIT_L(0); PG8_MMA(0, 1, At, B1); PG8_BAR;
            PG8_LDA(At, 1, 1); PG8_STAGE(PG8_SA(1, 0), a3, voffA);
            PG8_BAR; PG8_WAIT_L(0); PG8_MMA(1, 0, At, B0); PG8_BAR; PG8_SCHED;
            PG8_STAGE(PG8_SB(1, 1), b3 + hstep, voffB);
            PG8_WAIT_V(6); PG8_BAR; PG8_MMA(1, 1, At, B1); PG8_BAR;
            }
        }
        if constexpr (ALIGN_EPI) { if (wr == 0) PG8_BAR; }
        if constexpr (!Epi::AFTER_DRAIN) { E(acc, cur, wr, wc, fr, fq); S.done(cur); }
        if (!has_next) break;
#pragma unroll
        for (int a = 0; a < 2; ++a)
#pragma unroll
            for (int b = 0; b < 2; ++b)
#pragma unroll
                for (int m = 0; m < 4; ++m)
#pragma unroll
                    for (int n = 0; n < 2; ++n) acc[a][b][m][n] = (f32x4){0.f, 0.f, 0.f, 0.f};
        cur = nxt; cA = nA; cB = nB; ++ui;
        if constexpr (ALIGN_EPI) { if (wr == 1) PG8_BAR; }
    }
    PG8_WAIT_V(0);
    if constexpr (!ALIGN_EPI) { if (wr == 0) PG8_BAR; }
    PG8_BAR;
    if constexpr (Epi::AFTER_DRAIN) { E.fused(acc, cur, wr, wc, fr, fq, lds, wid, lane); S.done(cur); }
#undef PG8_SA
#undef PG8_SB
#undef PG8_STAGE
#undef PG8_LDA
#undef PG8_LDB
#undef PG8_MMA
#undef PG8_WAIT_V
#undef PG8_WAIT_L
#undef PG8_BAR
#undef PG8_SCHED
}
}

#define LAS __attribute__((address_space(3)))
typedef unsigned short bf16_t;
typedef short bf16x8 __attribute__((ext_vector_type(8)));
typedef short s16x4 __attribute__((ext_vector_type(4)));
typedef float f32x4 __attribute__((ext_vector_type(4)));
typedef unsigned u32x4 __attribute__((ext_vector_type(4)));
typedef unsigned u32x2 __attribute__((ext_vector_type(2)));
constexpr int T_TOK = 49152, DM = 1024, DFF = 2816, NLAYER = 4;
constexpr int GLA_N = 3104, GLA_NP = 3328, SWA_N = 1536;
constexpr float NORM_EPS = 1e-6f;
constexpr int NWAVES = 8;
constexpr int LDS_BYTES = 147456;
constexpr int MISC_OFF = LDS_BYTES - 64;
__device__ __forceinline__ unsigned f2bf(float f) { unsigned u = __builtin_bit_cast(unsigned, f); return (u + 0x7fffu + ((u >> 16) & 1u)) >> 16; }
__device__ __forceinline__ unsigned pk2(float lo, float hi) { return pg8::cvt_pk_bf16(lo, hi); }
__device__ __forceinline__ float bflo(unsigned w) { return __builtin_bit_cast(float, w << 16); }
__device__ __forceinline__ float bfhi(unsigned w) { return __builtin_bit_cast(float, w & 0xffff0000u); }
__device__ __forceinline__ float bf2f(bf16_t b) { return __builtin_bit_cast(float, ((unsigned)b) << 16); }
__device__ __forceinline__ float wave_sum(float v) {
#pragma unroll
    for (int o = 1; o < 64; o <<= 1) v += __shfl_xor(v, o);
    return v;
}
typedef short v4i16_t __attribute__((ext_vector_type(4)));
__device__ __forceinline__ s16x4 vtr(LAS const unsigned char* p) { return __builtin_bit_cast(s16x4, __builtin_amdgcn_ds_read_tr16_b64_v4i16((LAS v4i16_t*)p)); }
__device__ __forceinline__ bf16x8 cat8(s16x4 lo, s16x4 hi) { return (bf16x8){lo[0], lo[1], lo[2], lo[3], hi[0], hi[1], hi[2], hi[3]}; }
__device__ __forceinline__ bf16x8 packp(f32x4 a, f32x4 b) { u32x4 w; w.x = pk2(a[0], a[1]); w.y = pk2(a[2], a[3]); w.z = pk2(b[0], b[1]); w.w = pk2(b[2], b[3]); return __builtin_bit_cast(bf16x8, w); }
#define MFMA16(a, b, c) __builtin_amdgcn_mfma_f32_16x16x32_bf16((a), (b), (c), 0, 0, 0)
#define LDS_WAIT() asm volatile("s_waitcnt lgkmcnt(0)" ::: "memory")

__device__ __forceinline__ void tr_item(const float* W, const float* g, int K, int N, bf16_t* WT, int k0, int n0, int drow0, LAS float* scr, int lane) {
#pragma unroll 8
    for (int i = 0; i < 32; ++i) { const int kk = 2 * i + (lane >> 5); const float gv = g ? g[k0 + kk] : 1.0f; scr[kk * 33 + (lane & 31)] = W[(size_t)(k0 + kk) * N + n0 + (lane & 31)] * gv; }
    LDS_WAIT(); asm volatile("" ::: "memory");
    const int c = lane & 7;
#pragma unroll
    for (int j = 0; j < 4; ++j) { const int n = (lane >> 3) + 8 * j; const LAS float* s = scr + (8 * c) * 33 + n;
        u32x4 o; o.x = pk2(s[0 * 33], s[1 * 33]); o.y = pk2(s[2 * 33], s[3 * 33]); o.z = pk2(s[4 * 33], s[5 * 33]); o.w = pk2(s[6 * 33], s[7 * 33]);
        *(u32x4*)(WT + (size_t)(drow0 + n) * K + k0 + 8 * c) = o; }
    LDS_WAIT(); asm volatile("" ::: "memory");
}
struct Ptrs {
    const float *xp, *xs, *norm_g, *w1, *w2, *gla_in, *wgf, *bgf, *wgb, *bgb, *onorm, *gla_out, *swa_in, *sinks, *swa_out;
    float* out; unsigned char* ws;
};
__device__ __forceinline__ void convert_layer(const Ptrs& P, int L, LAS unsigned char* lds, int gw, int NGW, int wave, int lane) {
    LAS float* scr = (LAS float*)(lds + wave * 8448);
    const bool gla = (L & 1) == 0; const int j = L >> 1;
    const float* g = P.norm_g + (size_t)L * 6 * 1024;
    constexpr int I_W1 = 16 * 176, I_W2 = 44 * 32, I_GI = 16 * 97, I_SI = 16 * 48, I_MO = 16 * 32;
    const int i_mi = gla ? I_GI : I_SI;
    const int total = 2 * I_W1 + 2 * I_W2 + i_mi + I_MO;
    for (int it = gw; it < total; it += NGW) {
        int r = it;
        if (r < 2 * I_W1) { const int s = r / I_W1; r -= s * I_W1; const int kb = r / 176, nb = r % 176, n0 = nb * 32;
            const int jj = n0 < 2816 ? n0 : n0 - 2816; const int drow = 256 * (jj >> 7) + (n0 < 2816 ? 0 : 128) + (jj & 127);
            tr_item(P.w1 + (size_t)(L * 2 + s) * 1024 * 5632, g + (s ? 4 : 0) * 1024, 1024, 5632, (bf16_t*)(P.ws + (s ? WS_W1B : WS_W1A)), kb * 64, n0, drow, scr, lane); continue; }
        r -= 2 * I_W1;
        if (r < 2 * I_W2) { const int s = r / I_W2; r -= s * I_W2; const int kb = r / 32, nb = r % 32;
            tr_item(P.w2 + (size_t)(L * 2 + s) * 2816 * 1024, nullptr, 2816, 1024, (bf16_t*)(P.ws + (s ? WS_W2B : WS_W2A)), kb * 64, nb * 32, nb * 32, scr, lane); continue; }
        r -= 2 * I_W2;
        if (r < i_mi) {
            if (gla) { const int kb = r / 97, nb = r % 97; tr_item(P.gla_in + (size_t)j * 1024 * GLA_N, g + 2 * 1024, 1024, GLA_N, (bf16_t*)(P.ws + WS_WMI), kb * 64, nb * 32, nb * 32, scr, lane); }
            else     { const int kb = r / 48, nb = r % 48; tr_item(P.swa_in + (size_t)j * 1024 * SWA_N, g + 2 * 1024, 1024, SWA_N, (bf16_t*)(P.ws + WS_WMI), kb * 64, nb * 32, nb * 32, scr, lane); }
            continue; }
        r -= i_mi;
        { const int kb = r / 32, nb = r % 32; tr_item((gla ? P.gla_out : P.swa_out) + (size_t)j * 1024 * 1024, nullptr, 1024, 1024, (bf16_t*)(P.ws + WS_WMO), kb * 64, nb * 32, nb * 32, scr, lane); }
    }
    if (gla) {
        u32x4* z = (u32x4*)(P.ws + WS_WMI + (size_t)GLA_N * 1024 * 2);
        for (int i = gw * 64 + lane; i < 224 * 128; i += NGW * 64) z[i] = (u32x4){0u, 0u, 0u, 0u};
    }
}

__device__ __forceinline__ void init_rows(const Ptrs& P, int gw, int NGW, int lane) {
    float* X = P.out; bf16_t* XB = (bf16_t*)(P.ws + WS_XB); float* RS = (float*)(P.ws + WS_RS);
    for (int row = gw; row < T_TOK; row += NGW) {
        const float* src = row < 32768 ? P.xp + (size_t)row * DM : P.xs + (size_t)(row - 32768) * DM;
        const f32x4* xr = (const f32x4*)src + lane; f32x4* xo = (f32x4*)(X + (size_t)row * DM) + lane; u32x2* bo = (u32x2*)(XB + (size_t)row * DM) + lane;
        float s2 = 0.f;
#pragma unroll
        for (int j = 0; j < 4; ++j) { const f32x4 v = xr[64 * j]; s2 += (v[0] * v[0] + v[1] * v[1]) + (v[2] * v[2] + v[3] * v[3]); xo[64 * j] = v; bo[64 * j] = (u32x2){pk2(v[0], v[1]), pk2(v[2], v[3])}; }
        s2 = wave_sum(s2);
        if (lane == 0) RS[row] = rsqrtf(s2 * (1.0f / DM) + NORM_EPS);
    }
}
__device__ __forceinline__ void nr_rows(const Ptrs& P, const float* g, float c, int gw, int NGW, int lane) {
    float* X = P.out; bf16_t* XB = (bf16_t*)(P.ws + WS_XB); float* RS = (float*)(P.ws + WS_RS); const bf16_t* H = (const bf16_t*)(P.ws + WS_H);
    f32x4 gv[4];
#pragma unroll
    for (int j = 0; j < 4; ++j) gv[j] = ((const f32x4*)g)[lane + 64 * j];
    for (int row = gw; row < T_TOK; row += NGW) {
        f32x4* xr = (f32x4*)(X + (size_t)row * DM) + lane; const u32x2* hr = (const u32x2*)(H + (size_t)row * DM) + lane; u32x2* bo = (u32x2*)(XB + (size_t)row * DM) + lane;
        f32x4 xv[4], hv[4]; float ss = 0.f;
#pragma unroll
        for (int j = 0; j < 4; ++j) { xv[j] = xr[64 * j]; const u32x2 hw = hr[64 * j]; hv[j] = (f32x4){bflo(hw.x), bfhi(hw.x), bflo(hw.y), bfhi(hw.y)};
            ss += (hv[j][0] * hv[j][0] + hv[j][1] * hv[j][1]) + (hv[j][2] * hv[j][2] + hv[j][3] * hv[j][3]); }
        ss = wave_sum(ss);
        const float rs = rsqrtf(ss * (1.0f / DM) + NORM_EPS) * c; float s2 = 0.f;
#pragma unroll
        for (int j = 0; j < 4; ++j) { const f32x4 v = xv[j] + hv[j] * rs * gv[j]; s2 += (v[0] * v[0] + v[1] * v[1]) + (v[2] * v[2] + v[3] * v[3]); xr[64 * j] = v; bo[64 * j] = (u32x2){pk2(v[0], v[1]), pk2(v[2], v[3])}; }
        s2 = wave_sum(s2);
        if (lane == 0) RS[row] = rsqrtf(s2 * (1.0f / DM) + NORM_EPS);
    }
}

__device__ __forceinline__ void swa_phase(LAS unsigned char* lds, const bf16_t* Q, const bf16_t* Kb, const bf16_t* Vb, bf16_t* O, const float* sinks, int bid, int G, int tid) {
    const int lane = tid & 63, wave = __builtin_amdgcn_readfirstlane(tid >> 6), l16 = lane & 15, kg = lane >> 4, tq = (lane & 15) >> 2, tp = lane & 3;
    constexpr int KSTR = 144;
    LAS unsigned char* Ks = lds; LAS unsigned char* Vs = lds + 384 * KSTR;
    for (int unit = bid; unit < 1536; unit += G) {
        const int b = unit >> 2, kvh = unit & 3;
        int s0, nb; if (b < 256) { s0 = b & ~63; nb = 64; } else { s0 = 256 + ((b - 256) & ~15); nb = 16; }
        const int n = b - s0;
        for (int idx = tid; idx < 3072; idx += 512) {
            const int r = idx >> 3, c = idx & 7, bn = n - 1 + (r >> 7);
            u32x4 kv = (u32x4){0u, 0u, 0u, 0u}, vv = (u32x4){0u, 0u, 0u, 0u};
            if (bn >= 0 && bn < nb) { const size_t go = ((size_t)(s0 + bn) * 128 + (r & 127)) * 256 + kvh * 64 + 8 * c; kv = *(const u32x4*)(Kb + go); vv = *(const u32x4*)(Vb + go); }
            *(LAS u32x4*)(Ks + r * KSTR + c * 16) = kv; *(LAS u32x4*)(Vs + r * KSTR + c * 16) = vv;
        }
        __syncthreads();
        const int qh = kvh * 4 + (wave >> 1); const float sink = sinks[qh];
#pragma unroll 1
        for (int it = 0; it < 4; ++it) {
            const int qi = 16 * ((wave & 1) * 4 + it) + l16; const size_t qrow = (size_t)b * 128 + qi;
            bf16x8 qf[2];
#pragma unroll
            for (int kk = 0; kk < 2; ++kk) qf[kk] = *(const bf16x8*)(Q + qrow * 1024 + qh * 64 + 32 * kk + 8 * kg);
            f32x4 sc[24]; float mx = sink;
#pragma unroll
            for (int t = 0; t < 24; ++t) {
                f32x4 acc = (f32x4){0.f, 0.f, 0.f, 0.f};
#pragma unroll
                for (int kk = 0; kk < 2; ++kk) { const bf16x8 a = *(const LAS bf16x8*)(Ks + (16 * t + l16) * KSTR + (32 * kk + 8 * kg) * 2); acc = MFMA16(a, qf[kk], acc); }
                const int bn = n - 1 + (t >> 3); const bool bval = bn >= 0 && bn < nb;
#pragma unroll
                for (int j = 0; j < 4; ++j) { const int rel = 16 * t + 4 * kg + j - 128 - qi; const bool valid = bval && rel >= -128 && rel <= 128; acc[j] = valid ? acc[j] : -1e30f; mx = fmaxf(mx, acc[j]); }
                sc[t] = acc;
            }
            mx = fmaxf(mx, __shfl_xor(mx, 16)); mx = fmaxf(mx, __shfl_xor(mx, 32));
            float sum = 0.f;
#pragma unroll
            for (int t = 0; t < 24; ++t)
#pragma unroll
                for (int j = 0; j < 4; ++j) { const float p = sc[t][j] > -1e29f ? __expf(sc[t][j] - mx) : 0.f; sum += p; sc[t][j] = p; }
            sum += __shfl_xor(sum, 16); sum += __shfl_xor(sum, 32); sum += __expf(sink - mx);
            f32x4 o[4];
#pragma unroll
            for (int dt = 0; dt < 4; ++dt) o[dt] = (f32x4){0.f, 0.f, 0.f, 0.f};
#pragma unroll
            for (int u = 0; u < 12; ++u) {
                const bf16x8 pf = packp(sc[2 * u], sc[2 * u + 1]);
#pragma unroll
                for (int dt = 0; dt < 4; ++dt) {
                    const s16x4 lo = vtr(Vs + (32 * u + 4 * kg + tq) * KSTR + (16 * dt + 4 * tp) * 2), hi = vtr(Vs + (32 * u + 16 + 4 * kg + tq) * KSTR + (16 * dt + 4 * tp) * 2);
                    o[dt] = MFMA16(cat8(lo, hi), pf, o[dt]);
                }
            }
            const float inv = 1.0f / sum;
#pragma unroll
            for (int dt = 0; dt < 4; ++dt) *(u32x2*)(O + qrow * 1024 + qh * 64 + 16 * dt + 4 * kg) = (u32x2){pk2(o[dt][0] * inv, o[dt][1] * inv), pk2(o[dt][2] * inv, o[dt][3] * inv)};
        }
        __syncthreads();
    }
}

__device__ __forceinline__ void gla_pa(LAS unsigned char* lds, bf16_t* QK, bf16_t* QKB, const float* GD, float* DEC, const float* wgf, const float* bgf, const float* wgb, const float* bgb, int bid, int G, int tid) {
    LAS float* gds = (LAS float*)lds;
    const int col = tid;
    float wf[16], wb[16];
#pragma unroll
    for (int r = 0; r < 16; ++r) { wf[r] = wgf[r * 512 + col]; wb[r] = wgb[r * 512 + col]; }
    const float bf_ = bgf[col], bb_ = bgb[col];
    for (int cb = bid; cb < 384; cb += G) {
        const size_t r0 = (size_t)cb * 128;
#pragma unroll
        for (int i = 0; i < 2; ++i) { const int idx = tid + 512 * i; *(LAS f32x4*)(gds + 4 * idx) = *(const f32x4*)(GD + r0 * 32 + 4 * idx); }
        __syncthreads();
        float b = 0.f;
#pragma unroll 4
        for (int t = 127; t >= 0; --t) {
            float z = bb_;
#pragma unroll
            for (int r = 0; r < 16; ++r) z += gds[t * 32 + 16 + r] * wb[r];
            b += (fminf(z, 0.f) - __logf(1.0f + __expf(-fabsf(z)))) * 0.0625f;
            const size_t off = (r0 + t) * 1024 + col;
            const float q = bf2f(QK[off]), k = bf2f(QK[off + 512]);
            QKB[off] = (bf16_t)f2bf(q * __expf(b)); QKB[off + 512] = (bf16_t)f2bf(k * __expf(-b));
        }
        DEC[(size_t)(384 + cb) * 512 + col] = __expf(b);
        b = 0.f;
#pragma unroll 4
        for (int t = 0; t < 128; ++t) {
            float z = bf_;
#pragma unroll
            for (int r = 0; r < 16; ++r) z += gds[t * 32 + r] * wf[r];
            b += (fminf(z, 0.f) - __logf(1.0f + __expf(-fabsf(z)))) * 0.0625f;
            const size_t off = (r0 + t) * 1024 + col;
            const float q = bf2f(QK[off]), k = bf2f(QK[off + 512]);
            QK[off] = (bf16_t)f2bf(q * __expf(b)); QK[off + 512] = (bf16_t)f2bf(k * __expf(-b));
        }
        DEC[(size_t)cb * 512 + col] = __expf(b);
        __syncthreads();
    }
}
__device__ __forceinline__ void gla_pb(LAS unsigned char* lds, const bf16_t* V, const bf16_t* QK, const bf16_t* QKB, const float* DEC, bf16_t* ST, int bid, int G, int tid) {
    const int lane = tid & 63, wave = __builtin_amdgcn_readfirstlane(tid >> 6), l16 = lane & 15, kg = lane >> 4, tq = (lane & 15) >> 2, tp = lane & 3;
    constexpr int VSTR = 528, KSTR = 272;
    LAS unsigned char* Vs = lds; LAS unsigned char* KIs = lds + 128 * VSTR;
    for (int unit = bid; unit < 3072; unit += G) {
        const int dir = unit / 1536, rem = unit - dir * 1536, cb = rem >> 2, h = rem & 3;
        const bf16_t* KI = (dir ? QKB : QK) + 512 + h * 128; const size_t r0 = (size_t)cb * 128;
#pragma unroll
        for (int i = 0; i < 8; ++i) { const int idx = tid + 512 * i, r = idx >> 5, c = idx & 31; *(LAS u32x4*)(Vs + r * VSTR + c * 16) = *(const u32x4*)(V + (r0 + r) * 1024 + h * 256 + 8 * c); }
#pragma unroll
        for (int i = 0; i < 4; ++i) { const int idx = tid + 512 * i, r = idx >> 4, c = idx & 15; *(LAS u32x4*)(KIs + r * KSTR + c * 16) = *(const u32x4*)(KI + (r0 + r) * 1024 + 8 * c); }
        __syncthreads();
        f32x4 acc[8][2];
#pragma unroll
        for (int mt = 0; mt < 8; ++mt) { acc[mt][0] = (f32x4){0.f, 0.f, 0.f, 0.f}; acc[mt][1] = (f32x4){0.f, 0.f, 0.f, 0.f}; }
#pragma unroll
        for (int ks = 0; ks < 4; ++ks) {
            bf16x8 bfr[2];
#pragma unroll
            for (int nt = 0; nt < 2; ++nt) { LAS const unsigned char* p = Vs + (32 * ks + 8 * kg + tq) * VSTR + (32 * wave + 16 * nt + 4 * tp) * 2; bfr[nt] = cat8(vtr(p), vtr(p + 4 * VSTR)); }
#pragma unroll
            for (int mt = 0; mt < 8; ++mt) { LAS const unsigned char* p = KIs + (32 * ks + 8 * kg + tq) * KSTR + (16 * mt + 4 * tp) * 2; const bf16x8 afr = cat8(vtr(p), vtr(p + 4 * KSTR));
                acc[mt][0] = MFMA16(afr, bfr[0], acc[mt][0]); acc[mt][1] = MFMA16(afr, bfr[1], acc[mt][1]); }
        }
        const float* dp = DEC + (size_t)(dir * 384 + cb) * 512 + h * 128;
        bf16_t* dst = ST + (((size_t)dir * 384 + cb) * 4 + h) * 32768;
#pragma unroll
        for (int mt = 0; mt < 8; ++mt) { const int k0 = 16 * mt + 4 * kg; const f32x4 d4 = *(const f32x4*)(dp + k0);
#pragma unroll
            for (int nt = 0; nt < 2; ++nt) { const int v = 32 * wave + 16 * nt + l16; const f32x4 a = acc[mt][nt] * d4;
                *(u32x2*)(dst + (size_t)v * 128 + k0) = (u32x2){pk2(a[0], a[1]), pk2(a[2], a[3])}; } }
        __syncthreads();
    }
}
__device__ __forceinline__ void gla_pc(bf16_t* ST, const float* DEC, int bid, int G, int tid) {
    for (int vw = bid; vw < 768; vw += G) {
        const int item = vw * 512 + tid;
        int sd, e, nchunk, cb0;
        if (item < 131072) { sd = item >> 14; e = item & 16383; nchunk = 64; cb0 = (sd >> 1) * 64; }
        else { const int i2 = item - 131072; sd = i2 >> 14; e = i2 & 16383; nchunk = 16; cb0 = 256 + (sd >> 1) * 16; }
        const int dir = sd & 1, h = e >> 12, k0 = (e & 15) * 8;
        bf16_t* base = ST + (size_t)dir * 384 * 131072 + (size_t)e * 8;
        const float* dbase = DEC + (size_t)dir * 384 * 512 + h * 128 + k0;
        float S[8];
#pragma unroll
        for (int i = 0; i < 8; ++i) S[i] = 0.f;
        for (int c4 = 0; c4 < nchunk; c4 += 4) {
            u32x4 uu[4]; f32x4 d0[4], d1[4];
#pragma unroll
            for (int i = 0; i < 4; ++i) { const int cb = dir ? cb0 + nchunk - 1 - (c4 + i) : cb0 + c4 + i;
                uu[i] = *(const u32x4*)(base + (size_t)cb * 131072); d0[i] = *(const f32x4*)(dbase + (size_t)cb * 512); d1[i] = *(const f32x4*)(dbase + (size_t)cb * 512 + 4); }
#pragma unroll
            for (int i = 0; i < 4; ++i) { const int cb = dir ? cb0 + nchunk - 1 - (c4 + i) : cb0 + c4 + i;
                u32x4 w; w.x = pk2(S[0], S[1]); w.y = pk2(S[2], S[3]); w.z = pk2(S[4], S[5]); w.w = pk2(S[6], S[7]);
                *(u32x4*)(base + (size_t)cb * 131072) = w;
                S[0] = d0[i][0] * S[0] + bflo(uu[i].x); S[1] = d0[i][1] * S[1] + bfhi(uu[i].x); S[2] = d0[i][2] * S[2] + bflo(uu[i].y); S[3] = d0[i][3] * S[3] + bfhi(uu[i].y);
                S[4] = d1[i][0] * S[4] + bflo(uu[i].z); S[5] = d1[i][1] * S[5] + bfhi(uu[i].z); S[6] = d1[i][2] * S[6] + bflo(uu[i].w); S[7] = d1[i][3] * S[7] + bfhi(uu[i].w); }
        }
    }
}
__device__ __forceinline__ void gla_pd(LAS unsigned char* lds, const bf16_t* QK, const bf16_t* QKB, const bf16_t* V, bf16_t* R, const bf16_t* ST, const float* onorm, int bid, int G, int tid) {
    const int lane = tid & 63, wave = __builtin_amdgcn_readfirstlane(tid >> 6), l16 = lane & 15, kg = lane >> 4, tq = (lane & 15) >> 2, tp = lane & 3;
    constexpr int VSTR = 528, SSTR = 272;
    LAS unsigned char* Vs = lds; LAS unsigned char* STs = lds + 128 * VSTR;
    for (int unit = bid; unit < 1536; unit += G) {
        const int cb = unit >> 2, h = unit & 3; const size_t r0 = (size_t)cb * 128;
        __syncthreads();
#pragma unroll
        for (int i = 0; i < 8; ++i) { const int idx = tid + 512 * i, r = idx >> 5, c = idx & 31; *(LAS u32x4*)(Vs + r * VSTR + c * 16) = *(const u32x4*)(V + (r0 + r) * 1024 + h * 256 + 8 * c); }
        const int t_loc = 16 * wave + l16; const size_t trow = r0 + t_loc;
        f32x4 o[16], Pm[8];
#pragma unroll
        for (int i = 0; i < 16; ++i) o[i] = (f32x4){0.f, 0.f, 0.f, 0.f};
#pragma unroll
        for (int i = 0; i < 8; ++i) Pm[i] = (f32x4){0.f, 0.f, 0.f, 0.f};
#pragma unroll 1
        for (int dir = 0; dir < 2; ++dir) {
            const bf16_t* QD = (dir ? QKB : QK) + h * 128; const bf16_t* KI = QD + 512;
            const bf16_t* src = ST + (((size_t)dir * 384 + cb) * 4 + h) * 32768;
#pragma unroll
            for (int i = 0; i < 4; ++i) { const int idx = tid + 512 * i, r = idx >> 4, c = idx & 15; *(LAS u32x4*)(STs + r * SSTR + c * 16) = *(const u32x4*)(KI + (r0 + r) * 1024 + 8 * c); }
            bf16x8 qf[4];
#pragma unroll
            for (int ks = 0; ks < 4; ++ks) qf[ks] = *(const bf16x8*)(QD + trow * 1024 + 32 * ks + 8 * kg);
            __syncthreads();
#pragma unroll
            for (int st = 0; st < 8; ++st) {
                f32x4 acc = (f32x4){0.f, 0.f, 0.f, 0.f};
#pragma unroll
                for (int ks = 0; ks < 4; ++ks) { const bf16x8 a = *(const LAS bf16x8*)(STs + (16 * st + l16) * SSTR + (32 * ks + 8 * kg) * 2); acc = MFMA16(a, qf[ks], acc); }
#pragma unroll
                for (int j = 0; j < 4; ++j) { const int s = 16 * st + 4 * kg + j; const bool keep = dir ? (s >= t_loc) : (s <= t_loc); Pm[st][j] += keep ? acc[j] : 0.f; }
                if (st & 1) asm volatile("" ::: "memory");
            }
            __syncthreads();
#pragma unroll
            for (int i = 0; i < 8; ++i) { const int idx = tid + 512 * i, r = idx >> 4, c = idx & 15; *(LAS u32x4*)(STs + r * SSTR + c * 16) = *(const u32x4*)(src + (size_t)r * 128 + 8 * c); }
            __syncthreads();
#pragma unroll
            for (int vt = 0; vt < 16; ++vt) {
#pragma unroll
                for (int ks = 0; ks < 4; ++ks) { const bf16x8 a = *(const LAS bf16x8*)(STs + (16 * vt + l16) * SSTR + (32 * ks + 8 * kg) * 2); o[vt] = MFMA16(a, qf[ks], o[vt]); }
                if (vt & 1) asm volatile("" ::: "memory");
            }
            __syncthreads();
        }
#pragma unroll
        for (int u = 0; u < 4; ++u) {
            const bf16x8 pf = packp(Pm[2 * u], Pm[2 * u + 1]);
#pragma unroll
            for (int vt = 0; vt < 16; ++vt) {
                const s16x4 lo = vtr(Vs + (32 * u + 4 * kg + tq) * VSTR + (16 * vt + 4 * tp) * 2), hi = vtr(Vs + (32 * u + 16 + 4 * kg + tq) * VSTR + (16 * vt + 4 * tp) * 2);
                o[vt] = MFMA16(cat8(lo, hi), pf, o[vt]);
                if ((vt & 3) == 3) asm volatile("" ::: "memory");
            }
        }
        float ss = 0.f;
#pragma unroll
        for (int vt = 0; vt < 16; ++vt) ss += (o[vt][0] * o[vt][0] + o[vt][1] * o[vt][1]) + (o[vt][2] * o[vt][2] + o[vt][3] * o[vt][3]);
        ss += __shfl_xor(ss, 16); ss += __shfl_xor(ss, 32);
        const float rs = rsqrtf(ss * (1.0f / 256.0f) + NORM_EPS);
#pragma unroll
        for (int vt = 0; vt < 16; ++vt) { const int vcol = h * 256 + 16 * vt + 4 * kg; const f32x4 gn = *(const f32x4*)(onorm + vcol);
            u32x2* yp = (u32x2*)(R + trow * 1024 + vcol); const u32x2 rw = *yp;
            const f32x4 y = o[vt] * rs * gn * (f32x4){bflo(rw.x), bfhi(rw.x), bflo(rw.y), bfhi(rw.y)};
            *yp = (u32x2){pk2(y[0], y[1]), pk2(y[2], y[3])};
            if ((vt & 3) == 3) asm volatile("" ::: "memory"); }
    }
}

#define XB_TMO      128
#define XB_XCNT(j)  (256  + 64 * (j))
#define XB_XSUB(j)  (1280 + 64 * (j))
#define XB_XGEN(j)  (2304 + 64 * (j))
#define XB_TOP      3328
#define XB_TOPGEN   3392
#define XCD_BAR_WORDS 3456
#define XB_SPIN_CAP (1u << 18)

__device__ __forceinline__ unsigned xb_ld(unsigned* p)              { return __hip_atomic_load(p, __ATOMIC_RELAXED, __HIP_MEMORY_SCOPE_AGENT); }
__device__ __forceinline__ unsigned xb_add(unsigned* p, unsigned v) { return __hip_atomic_fetch_add(p, v, __ATOMIC_RELAXED, __HIP_MEMORY_SCOPE_AGENT); }
__device__ __forceinline__ unsigned xb_xcc_id() { return (unsigned)__builtin_amdgcn_s_getreg((3 << 11) | 20) & 0xFu; }
#define XB_SPIN(cond, bar) do { unsigned _sp = 0; while (cond) { __builtin_amdgcn_s_sleep(1); \
    if ((++_sp & 255u) == 0u) { if (xb_ld(&(bar)[XB_TMO])) break; if (_sp > XB_SPIN_CAP) { atomicAdd(&(bar)[XB_TMO], 1u); break; } } } } while (0)

struct XcdBarrier {
    unsigned* bar; unsigned x;
    volatile LAS unsigned* st;
};

__device__ __forceinline__ XcdBarrier xcd_barrier_post(unsigned* bar, volatile LAS unsigned* st) {
    XcdBarrier b; b.bar = bar; b.x = xb_xcc_id(); b.st = st;
    if (threadIdx.x == 0) (void)xb_add(&bar[XB_XCNT(b.x)], 1u);
    return b;
}
__device__ __forceinline__ void xcd_barrier_complete(unsigned* bar, unsigned x, unsigned& nloc, unsigned& nx) {
    const unsigned G = gridDim.x * gridDim.y * gridDim.z;
    unsigned sum, cnt, mine, sp = 0u;
    for (;;) {
        sum = 0u; cnt = 0u; mine = 0u;
#pragma unroll
        for (unsigned j = 0; j < 16; ++j) { const unsigned c = xb_ld(&bar[XB_XCNT(j)]); sum += c; cnt += (c > 0u) ? 1u : 0u; mine = (j == x) ? c : mine; }
        if (sum == G) break;
        __builtin_amdgcn_s_sleep(1);
        if ((++sp & 255u) == 0u) { if (xb_ld(&bar[XB_TMO])) break; if (sp > XB_SPIN_CAP) { atomicAdd(&bar[XB_TMO], 1u); break; } }
    }
    nloc = mine > 0u ? mine : 1u; nx = cnt > 0u ? cnt : 1u;
}

__device__ __forceinline__ void xcd_barrier(const XcdBarrier& b) {
    asm volatile("s_waitcnt vmcnt(0)" ::: "memory");
    __syncthreads();
    if (threadIdx.x == 0) {
        unsigned* bar = b.bar;
        __builtin_amdgcn_s_waitcnt(0);
        unsigned nloc = b.st[0], nx = b.st[1];
        if (nloc == 0u) { xcd_barrier_complete(bar, b.x, nloc, nx); b.st[0] = nloc; b.st[1] = nx; }
        const unsigned old = xb_add(&bar[XB_XSUB(b.x)], 1u);
        const unsigned gen = old / nloc;
        if (old + 1u == (gen + 1u) * nloc) {
            __builtin_amdgcn_fence(__ATOMIC_RELEASE, "agent");
            asm volatile("s_waitcnt vmcnt(0)" ::: "memory");
            const unsigned og = xb_add(&bar[XB_TOP], 1u);
            const unsigned tg = og / nx;
            if (og + 1u == (tg + 1u) * nx) xb_add(&bar[XB_TOPGEN], 1u);
            else XB_SPIN(xb_ld(&bar[XB_TOPGEN]) == tg, bar);
            __builtin_amdgcn_fence(__ATOMIC_ACQUIRE, "agent");
            xb_add(&bar[XB_XGEN(b.x)], 1u);
            asm volatile("s_waitcnt vmcnt(0)" ::: "memory");
        } else {
            XB_SPIN(xb_ld(&bar[XB_XGEN(b.x)]) == gen, bar);
            __builtin_amdgcn_fence(__ATOMIC_ACQUIRE, "agent");
            asm volatile("s_waitcnt vmcnt(0)" ::: "memory");
        }
    }
    __syncthreads();
}

struct Args { const float* in[15]; float* out; unsigned char* ws; float inv_freq[8]; int ph_lo, ph_hi, coop, pad; };
constexpr int PH_PER_LAYER = 13, N_PHASES = 1 + NLAYER * PH_PER_LAYER;
__host__ __device__ inline bool phase_empty(int ph) { if (ph == 0) return false; const int L = (ph - 1) / PH_PER_LAYER, sub = (ph - 1) % PH_PER_LAYER; return (L & 1) && sub >= 5 && sub <= 7; }

__global__ void __launch_bounds__(NWAVES * 64, 2) fwd_kernel(Args a) {
    extern __shared__ __attribute__((aligned(16))) unsigned char lds_raw[];
    LAS unsigned char* lds = (LAS unsigned char*)lds_raw;
    const int G = gridDim.x, bid = blockIdx.x;
    volatile LAS unsigned* MISC = (volatile LAS unsigned*)(lds + MISC_OFF);
    if (threadIdx.x < 16) MISC[threadIdx.x] = 0u;
    __syncthreads();
    XcdBarrier xbar; xbar.bar = (unsigned*)(a.ws + WS_CTL); xbar.x = 0; xbar.st = MISC;
    if (a.coop) xbar = xcd_barrier_post((unsigned*)(a.ws + WS_CTL), MISC);
    int nsync = 0;
    bool first = true;
#ifndef PROBE_DUP
#define PROBE_DUP 0
#endif
    for (int it = 2 * a.ph_lo; it < 2 * a.ph_hi; ++it) {
        const int ph = it >> 1;
        if (phase_empty(ph)) continue;
        if (it & 1) { if (ph == 0) continue; const int sub_ = (ph - 1) % PH_PER_LAYER; const bool gla_ = ((((ph - 1) / PH_PER_LAYER) & 1) == 0);
            const bool dup = ((PROBE_DUP & 1) && (sub_ == 0 || sub_ == 10 || sub_ == 1 || sub_ == 11 || sub_ == 3 || sub_ == 8)) || ((PROBE_DUP & 4) && (sub_ == 5 || (sub_ == 4 && !gla_)));
            if (!dup) continue; }
        if (!first && a.coop) { if (nsync == 0) cg::this_grid().sync(); else xcd_barrier(xbar); ++nsync; }
        first = false;
        int tid = threadIdx.x; asm volatile("" : "+v"(tid));
        const int lane = tid & 63, wave = __builtin_amdgcn_readfirstlane(tid >> 6), gw = bid * NWAVES + wave, NGW = G * NWAVES;
        unsigned char* ws = a.ws; asm volatile("" : "+s"(ws));
        Ptrs P; P.xp = a.in[0]; P.xs = a.in[1]; P.norm_g = a.in[2]; P.w1 = a.in[3]; P.w2 = a.in[4]; P.gla_in = a.in[5]; P.wgf = a.in[6]; P.bgf = a.in[7]; P.wgb = a.in[8]; P.bgb = a.in[9];
        P.onorm = a.in[10]; P.gla_out = a.in[11]; P.swa_in = a.in[12]; P.sinks = a.in[13]; P.swa_out = a.in[14]; P.out = a.out; P.ws = ws;
        bf16_t* XB = (bf16_t*)(ws + WS_XB); bf16_t* HB = (bf16_t*)(ws + WS_H); const float* RS = (const float*)(ws + WS_RS);
        if (ph == 0) {
            init_rows(P, gw, NGW, lane);
            float* rope = (float*)(ws + WS_ROPE);
            for (int i = bid * 512 + tid; i < 8192 * 8; i += G * 512) { const int pos = i >> 3, f = i & 7;
                double rev = (double)pos * (double)a.inv_freq[f] * 0.15915494309189535; rev -= floor(rev);
                rope[pos * 16 + f] = __builtin_amdgcn_cosf((float)rev); rope[pos * 16 + 8 + f] = __builtin_amdgcn_sinf((float)rev); }
            convert_layer(P, 0, lds, gw, NGW, wave, lane);
            continue;
        }
        const int L = (ph - 1) / PH_PER_LAYER, sub = (ph - 1) % PH_PER_LAYER; const bool gla = (L & 1) == 0; const int j = L >> 1;
        const float* g = P.norm_g + (size_t)L * 6 * 1024;
        switch (sub) {
        case 0: case 10: {
            pg8::Gemm gm{XB, (const bf16_t*)(ws + (sub == 0 ? WS_W1A : WS_W1B)), T_TOK, 2 * DFF, DM}; pg8::StaticOrder S; S.init(T_TOK, 2 * DFF, G, bid);
            pg8::EpiSwiGLU E{(bf16_t*)(ws + WS_B), RS};
            pg8::gemm_phase<pg8::EpiSwiGLU, pg8::StaticOrder, true, true>(lds, gm, S, E, tid);
        } break;
        case 1: case 11: {
            pg8::Gemm gm{(const bf16_t*)(ws + WS_B), (const bf16_t*)(ws + (sub == 1 ? WS_W2A : WS_W2B)), T_TOK, DM, DFF}; pg8::StaticOrder S; S.init(T_TOK, DM, G, bid);
            pg8::EpiPlain E{HB, DM};
            pg8::gemm_phase<pg8::EpiPlain, pg8::StaticOrder, true, true>(lds, gm, S, E, tid);
        } break;
        case 2: nr_rows(P, g + 1 * 1024, 0.5f, gw, NGW, lane); if (PROBE_DUP & 2) { __syncthreads(); nr_rows(P, g + 1 * 1024, 0.0f, gw, NGW, lane); } break;
        case 9: nr_rows(P, g + 3 * 1024, 1.0f, gw, NGW, lane); if (PROBE_DUP & 2) { __syncthreads(); nr_rows(P, g + 3 * 1024, 0.0f, gw, NGW, lane); } break;
        case 12: nr_rows(P, g + 5 * 1024, 0.5f, gw, NGW, lane); if (PROBE_DUP & 2) { __syncthreads(); nr_rows(P, g + 5 * 1024, 0.0f, gw, NGW, lane); } if (L + 1 < NLAYER) convert_layer(P, L + 1, lds, gw, NGW, wave, lane); break;
        case 3: {
            if (gla) {
                pg8::Gemm gm{XB, (const bf16_t*)(ws + WS_WMI), T_TOK, GLA_NP, DM}; pg8::StaticOrder S; S.init(T_TOK, GLA_NP, G, bid);
                pg8::EpiGlaIn E{ws, RS};
                pg8::gemm_phase<pg8::EpiGlaIn, pg8::StaticOrder, true, true>(lds, gm, S, E, tid);
            } else {
                pg8::Gemm gm{XB, (const bf16_t*)(ws + WS_WMI), T_TOK, SWA_N, DM}; pg8::StaticOrder S; S.init(T_TOK, SWA_N, G, bid);
                pg8::EpiSwaIn E{ws, RS};
                pg8::gemm_phase<pg8::EpiSwaIn, pg8::StaticOrder, true, true>(lds, gm, S, E, tid);
            }
        } break;
        case 4:
            if (gla) gla_pa(lds, HB, XB, (const float*)(ws + WS_GD), (float*)(ws + WS_DEC), P.wgf + (size_t)j * 16 * 512, P.bgf + j * 512, P.wgb + (size_t)j * 16 * 512, P.bgb + j * 512, bid, G, tid);
            else swa_phase(lds, (const bf16_t*)(ws + WS_SQ), (const bf16_t*)(ws + WS_SK), (const bf16_t*)(ws + WS_SV), (bf16_t*)(ws + WS_SO), P.sinks + j * 16, bid, G, tid);
            break;
        case 5: gla_pb(lds, (const bf16_t*)(ws + WS_GV), HB, XB, (const float*)(ws + WS_DEC), (bf16_t*)(ws + WS_ST), bid, G, tid); break;
        case 6: gla_pc((bf16_t*)(ws + WS_ST), (const float*)(ws + WS_DEC), bid, G, tid); break;
        case 7: gla_pd(lds, HB, XB, (const bf16_t*)(ws + WS_GV), (bf16_t*)(ws + WS_GR), (const bf16_t*)(ws + WS_ST), P.onorm + j * 1024, bid, G, tid); break;
        case 8: {
            pg8::Gemm gm{(const bf16_t*)(ws + (gla ? WS_GR : WS_SO)), (const bf16_t*)(ws + WS_WMO), T_TOK, DM, DM}; pg8::StaticOrder S; S.init(T_TOK, DM, G, bid);
            pg8::EpiPlain E{HB, DM};
            pg8::gemm_phase<pg8::EpiPlain, pg8::StaticOrder, true, true>(lds, gm, S, E, tid);
        } break;
        default: break;
        }
    }
}

extern "C" void kernel_launch(void* const* d_in, const int* in_sizes, int n_in, void* d_out, int out_size, void* d_ws, size_t ws_size, hipStream_t stream) {
    static int grid = 0;
    if (grid == 0) {
        if (n_in != 15 || out_size != T_TOK * DM || ws_size < WS_END) { fprintf(stderr, "kernel_launch: unexpected shapes (n_in %d out %d ws %zu, need %zu); nothing launched\n", n_in, out_size, ws_size, (size_t)WS_END); grid = -1; return; }
        int dev = 0, cus = 0, per_cu = 0;
        if (hipGetDevice(&dev) != hipSuccess || hipDeviceGetAttribute(&cus, hipDeviceAttributeMultiprocessorCount, dev) != hipSuccess) { grid = -1; return; }
        if (hipFuncSetAttribute((const void*)fwd_kernel, hipFuncAttributeMaxDynamicSharedMemorySize, LDS_BYTES) != hipSuccess) { fprintf(stderr, "kernel_launch: hipFuncSetAttribute failed\n"); grid = -1; return; }
        if (hipOccupancyMaxActiveBlocksPerMultiprocessor(&per_cu, (const void*)fwd_kernel, NWAVES * 64, LDS_BYTES) != hipSuccess || per_cu < 1) { fprintf(stderr, "kernel_launch: occupancy query says %d\n", per_cu); per_cu = 1; }
        (void)hipGetLastError();
        grid = cus * per_cu;
    }
    if (grid < 0) return;
    if (hipMemsetAsync((char*)d_ws + WS_CTL, 0, 65536, stream) != hipSuccess) { fprintf(stderr, "kernel_launch: memset failed\n"); return; }
    Args a{};
    for (int i = 0; i < 15; ++i) a.in[i] = (const float*)d_in[i];
    a.out = (float*)d_out; a.ws = (unsigned char*)d_ws;
    for (int i = 0; i < 8; ++i) a.inv_freq[i] = (float)std::pow(500000.0, -(double)i / 8.0);
#if MK_MULTI_LAUNCH
    a.coop = 0;
    for (int ph = 0; ph < N_PHASES; ++ph) {
        if (phase_empty(ph)) continue;
        a.ph_lo = ph; a.ph_hi = ph + 1;
        hipLaunchKernelGGL(fwd_kernel, dim3(grid), dim3(NWAVES * 64), LDS_BYTES, stream, a);
    }
#else
    a.coop = 1; a.ph_lo = 0; a.ph_hi = N_PHASES;
    void* args[] = {&a};
    hipError_t e = hipLaunchCooperativeKernel((const void*)fwd_kernel, dim3(grid), dim3(NWAVES * 64), args, LDS_BYTES, stream);
    if (e != hipSuccess) fprintf(stderr, "kernel_launch: cooperative launch failed: %s (grid %d)\n", hipGetErrorString(e), grid);
#endif
}
```
